# Optimizing an MI355X kernel written in HIP

```python
import math
import jax, jax.numpy as jnp
from jax import lax
import numpy as np

D_MODEL = 1024
BATCH = 2
SEQ = 8192
DEPTH = 2

QBLK = 128
NORM_EPS = 1e-6
ROPE_BASE = 10000.0
MAX_POS_OFFSET = 4096

A_HEADS = 8
A_HEAD_DIM = 64
IDX_HEADS = 4
IDX_DIM = 64
DSA_TOPK = 256
A_WIDTH = A_HEADS * A_HEAD_DIM
B_HEADS = 4
B_QK_DIM = 64
B_V_DIM = 128
RET_CHUNK = 128
B_WIDTH = B_HEADS * B_V_DIM
C_HEADS = 4
C_QK_DIM = 64
C_V_DIM = 128
C_WIDTH = C_HEADS * C_V_DIM
D_HEADS = 8
D_NOPE_DIM = 64
D_ROPE_DIM = 32
D_V_DIM = 64
D_Q_LORA = 256
D_KV_LORA = 128
D_WIDTH = D_HEADS * D_V_DIM

EVEN_MIX_WIDTH = A_WIDTH + B_WIDTH
ODD_MIX_WIDTH = C_WIDTH + D_WIDTH
EVEN_WIDTHS = (A_WIDTH, A_WIDTH, A_WIDTH, A_WIDTH,
               IDX_HEADS * IDX_DIM, IDX_DIM, IDX_HEADS,
               B_HEADS * B_QK_DIM, B_HEADS * B_QK_DIM,
               B_WIDTH, B_WIDTH)
ODD_WIDTHS = (C_HEADS * 2 * C_QK_DIM, C_HEADS * 2 * C_QK_DIM,
              C_WIDTH, C_WIDTH,
              D_Q_LORA, D_KV_LORA, D_ROPE_DIM, D_WIDTH)
EVEN_IN = sum(EVEN_WIDTHS)
ODD_IN = sum(ODD_WIDTHS)

kernel_name = 'hybrid_dsa_retention_diffattn_mla'


def split_columns(h, widths):
    out, start = [], 0
    for w in widths:
        out.append(h[..., start:start + w])
        start += w
    return out


def rms_norm(x, gain=None):
    xf = x.astype(jnp.float32)
    y = xf * lax.rsqrt(jnp.mean(xf * xf, axis=-1, keepdims=True) + NORM_EPS)
    if gain is not None:
        y = y * gain.astype(jnp.float32)
    return y.astype(x.dtype)


def head_group_norm(x):
    xf = x.astype(jnp.float32)
    mu = jnp.mean(xf, axis=-1, keepdims=True)
    var = jnp.mean(jnp.square(xf - mu), axis=-1, keepdims=True)
    return ((xf - mu) * lax.rsqrt(var + NORM_EPS)).astype(x.dtype)


def rotary(x, positions):
    half = x.shape[-1] // 2
    inv_freq = ROPE_BASE ** (-jnp.arange(half, dtype=jnp.float32) / half)
    ang = positions.astype(jnp.float32)[:, :, None, None] * inv_freq
    cos, sin = jnp.cos(ang), jnp.sin(ang)
    xf = x.astype(jnp.float32)
    x1, x2 = xf[..., :half], xf[..., half:]
    return jnp.concatenate([x1 * cos - x2 * sin, x1 * sin + x2 * cos], axis=-1).astype(x.dtype)


def to_blocks(a, nb):
    b = a.shape[0]
    return a.reshape((b, nb, QBLK) + a.shape[2:]).swapaxes(0, 1)


def from_blocks(a):
    nb, b, q = a.shape[:3]
    return a.swapaxes(0, 1).reshape((b, nb * q) + a.shape[3:])


def causal_attention(q, k, v, scale):
    t = q.shape[1]
    nb = t // QBLK
    kpos = jnp.arange(t)

    def block(args):
        qb, i = args
        qpos = i * QBLK + jnp.arange(QBLK)
        s = jnp.einsum('bqhd,bkhd->bhqk', qb, k).astype(jnp.float32) * scale
        s = jnp.where((kpos[None, :] <= qpos[:, None])[None, None], s, -jnp.inf)
        p = jax.nn.softmax(s, axis=-1).astype(v.dtype)
        return jnp.einsum('bhqk,bkhd->bqhd', p, v)

    out = lax.map(block, (to_blocks(q, nb), jnp.arange(nb)))
    return from_blocks(out)


def dsa_attention(q, k, v, q_idx, k_idx, w_idx):
    b, t, h, d = q.shape
    topk = min(DSA_TOPK, t // 4)
    nb = t // QBLK
    kpos = jnp.arange(t)
    w_idx = w_idx * (IDX_HEADS ** -0.5 * IDX_DIM ** -0.5)
    gather = jax.vmap(lambda a, ix: a[ix])

    def block(args):
        qb, qib, wb, i = args
        qpos = i * QBLK + jnp.arange(QBLK)
        causal = kpos[None, :] <= qpos[:, None]
        rel = jax.nn.relu(jnp.einsum('bqhd,bsd->bqhs', qib, k_idx))
        score = jnp.einsum('bqh,bqhs->bqs', wb, rel).astype(jnp.float32)
        score = jnp.where(causal[None], score, -jnp.inf)
        _, sel = lax.top_k(score, topk)
        valid = sel <= qpos[None, :, None]
        ks = gather(k, sel).reshape(b, QBLK, topk, h, d)
        vs = gather(v, sel).reshape(b, QBLK, topk, h, d)
        s = jnp.einsum('bqhd,bqkhd->bqhk', qb, ks).astype(jnp.float32) * (d ** -0.5)
        s = jnp.where(valid[:, :, None, :], s, -jnp.inf)
        p = jax.nn.softmax(s, axis=-1).astype(vs.dtype)
        return jnp.einsum('bqhk,bqkhd->bqhd', p, vs)

    out = lax.map(block, (to_blocks(q, nb), to_blocks(q_idx, nb), to_blocks(w_idx, nb), jnp.arange(nb)))
    return from_blocks(out).reshape(b, t, h * d)


def retention(q, k, v):
    b, t, h, dk = q.shape
    dv = v.shape[-1]
    c = RET_CHUNK
    n = t // c
    gammas = 1.0 - 2.0 ** (-5.0 - jnp.arange(h, dtype=jnp.float32))
    log_g = jnp.log(gammas)
    q = q.reshape(b, n, c, h, dk)
    k = k.reshape(b, n, c, h, dk)
    v = v.reshape(b, n, c, h, dv)
    idx = jnp.arange(c)
    diff = idx[:, None] - idx[None, :]
    decay = jnp.where(diff[None] >= 0, jnp.exp(diff[None].astype(jnp.float32) * log_g[:, None, None]), 0.0)
    s = jnp.einsum('bnihd,bnjhd->bnhij', q, k) * decay
    intra = jnp.einsum('bnhij,bnjhe->bnihe', s, v)
    zeta = jnp.exp((c - 1 - idx).astype(jnp.float32)[:, None] * log_g[None, :])
    xi = jnp.exp((idx + 1).astype(jnp.float32)[:, None] * log_g[None, :])
    u = jnp.einsum('bnjhd,jh,bnjhe->nbhde', k, zeta, v)
    g_chunk = jnp.exp(c * log_g)[None, :, None, None]

    def step(state, inc):
        return g_chunk * state + inc, state

    _, s_prev = lax.scan(step, jnp.zeros((b, h, dk, dv), u.dtype), u)
    cross = jnp.einsum('bnihd,ih,nbhde->bnihe', q, xi, s_prev)
    return (intra + cross).reshape(b, t, h, dv).astype(v.dtype)


def even_mixer(h, positions, w_in, w_out):
    b, t, _ = h.shape
    (aq, ak, av, ag, iq, ik, iw, bq, bk, bv, bg) = split_columns(h @ w_in, EVEN_WIDTHS)
    a = dsa_attention(aq.reshape(b, t, A_HEADS, A_HEAD_DIM), ak, av,
                      iq.reshape(b, t, IDX_HEADS, IDX_DIM), ik, iw)
    a = a * jax.nn.silu(ag)
    q = rotary(bq.reshape(b, t, B_HEADS, B_QK_DIM), positions)
    k = rotary(bk.reshape(b, t, B_HEADS, B_QK_DIM), positions) * (B_QK_DIM ** -0.5)
    r = head_group_norm(retention(q, k, bv.reshape(b, t, B_HEADS, B_V_DIM)))
    r = r.reshape(b, t, B_WIDTH) * jax.nn.silu(bg)
    return jnp.concatenate([a, r], axis=-1) @ w_out


def odd_mixer(h, positions, w_in, w_out, lam_params, subln, q_norm, kv_norm, w_uq, w_ukv, layer):
    b, t, _ = h.shape
    (cq, ck, cv, cg, dcq, dckv, dkr, dg) = split_columns(h @ w_in, ODD_WIDTHS)
    q = cq.reshape(b, t, C_HEADS, 2 * C_QK_DIM)
    k = ck.reshape(b, t, C_HEADS, 2 * C_QK_DIM)
    v = cv.reshape(b, t, C_HEADS, C_V_DIM)
    qs = jnp.concatenate([q[..., :C_QK_DIM], q[..., C_QK_DIM:]], axis=2)
    ks = jnp.concatenate([k[..., :C_QK_DIM], k[..., C_QK_DIM:]], axis=2)
    o = causal_attention(qs, ks, jnp.concatenate([v, v], axis=2), C_QK_DIM ** -0.5)
    lam_init = 0.8 - 0.6 * math.exp(-0.3 * layer)
    lam = (jnp.exp(jnp.sum(lam_params[0] * lam_params[1]))
           - jnp.exp(jnp.sum(lam_params[2] * lam_params[3])) + lam_init)
    c = rms_norm(o[:, :, :C_HEADS] - lam * o[:, :, C_HEADS:], subln) * (1.0 - lam_init)
    c = c.reshape(b, t, C_WIDTH) * jax.nn.silu(cg)
    qd = (rms_norm(dcq, q_norm) @ w_uq).reshape(b, t, D_HEADS, D_NOPE_DIM + D_ROPE_DIM)
    kv = (rms_norm(dckv, kv_norm) @ w_ukv).reshape(b, t, D_HEADS, D_NOPE_DIM + D_V_DIM)
    q_full = jnp.concatenate([qd[..., :D_NOPE_DIM], rotary(qd[..., D_NOPE_DIM:], positions)], axis=-1)
    k_rope = jnp.broadcast_to(rotary(dkr[:, :, None, :], positions), (b, t, D_HEADS, D_ROPE_DIM))
    k_full = jnp.concatenate([kv[..., :D_NOPE_DIM], k_rope], axis=-1)
    m = causal_attention(q_full, k_full, kv[..., D_NOPE_DIM:], (D_NOPE_DIM + D_ROPE_DIM) ** -0.5)
    m = m.reshape(b, t, D_WIDTH) * jax.nn.silu(dg)
    return jnp.concatenate([c, m], axis=-1) @ w_out


def setup_inputs(seed: int = 0) -> dict:
    key = jax.random.key(seed)
    ks = jax.random.split(key, 16)
    n_even = (DEPTH + 1) // 2
    n_odd = DEPTH // 2
    nrm = jax.random.normal
    f32 = jnp.float32
    x = nrm(ks[0], (BATCH, SEQ, D_MODEL), f32)
    offset = jax.random.randint(ks[1], (BATCH, 1), 0, MAX_POS_OFFSET)
    positions = (offset + jnp.arange(SEQ)[None, :]).astype(jnp.int32)
    return {
        'x': x,
        'positions': positions,
        'pre_norm': 1.0 + 0.02 * nrm(ks[2], (DEPTH, D_MODEL), f32),
        'post_norm': 1.0 + 0.02 * nrm(ks[3], (DEPTH, D_MODEL), f32),
        'w_in_even': nrm(ks[4], (n_even, D_MODEL, EVEN_IN), f32) * D_MODEL ** -0.5,
        'w_out_even': nrm(ks[5], (n_even, EVEN_MIX_WIDTH, D_MODEL), f32) * EVEN_MIX_WIDTH ** -0.5,
        'w_in_odd': nrm(ks[6], (n_odd, D_MODEL, ODD_IN), f32) * D_MODEL ** -0.5,
        'diff_lambda': 0.1 * nrm(ks[7], (n_odd, 4, C_QK_DIM), f32),
        'diff_subln': 1.0 + 0.02 * nrm(ks[8], (n_odd, C_V_DIM), f32),
        'mla_q_norm': 1.0 + 0.02 * nrm(ks[9], (n_odd, D_Q_LORA), f32),
        'mla_kv_norm': 1.0 + 0.02 * nrm(ks[10], (n_odd, D_KV_LORA), f32),
        'mla_w_uq': nrm(ks[11], (n_odd, D_Q_LORA, D_HEADS * (D_NOPE_DIM + D_ROPE_DIM)), f32) * D_Q_LORA ** -0.5,
        'mla_w_ukv': nrm(ks[12], (n_odd, D_KV_LORA, D_HEADS * (D_NOPE_DIM + D_V_DIM)), f32) * D_KV_LORA ** -0.5,
        'w_out_odd': nrm(ks[13], (n_odd, ODD_MIX_WIDTH, D_MODEL), f32) * ODD_MIX_WIDTH ** -0.5,
    }


def reference(x, positions, pre_norm, post_norm, w_in_even, w_out_even, w_in_odd,
              diff_lambda, diff_subln, mla_q_norm, mla_kv_norm, mla_w_uq, mla_w_ukv, w_out_odd):
    for layer in range(DEPTH):
        h = rms_norm(x, pre_norm[layer])
        j = layer // 2
        if layer % 2 == 0:
            m = even_mixer(h, positions, w_in_even[j], w_out_even[j])
        else:
            m = odd_mixer(h, positions, w_in_odd[j], w_out_odd[j], diff_lambda[j], diff_subln[j],
                          mla_q_norm[j], mla_kv_norm[j], mla_w_uq[j], mla_w_ukv[j], layer)
        x = x + rms_norm(m, post_norm[layer])
    return x
```

```cpp
#include <hip/hip_runtime.h>
#include <cstdio>
#include <cstdint>
#ifndef MK_STAGE
#define MK_STAGE 3
#endif
#define DBG_SMASK_SHFL 1
#ifndef MK_N_LAUNCHES
#define MK_N_LAUNCHES 1
#endif
namespace pg8 {
#define PG8_LAS __attribute__((address_space(3)))
typedef unsigned short bf16_t;
typedef short bf16x8 __attribute__((ext_vector_type(8)));
typedef float f32x4 __attribute__((ext_vector_type(4)));
typedef unsigned u32x4 __attribute__((ext_vector_type(4)));
constexpr int BM = 256, BK = 64, HALF = 128, HTB = HALF * BK * 2  , STAGE_BYTES = 8 * HTB, NXCD = 8, WGM = 8;

__host__ __device__ __forceinline__ int lds_byte(int r, int c) { const int st = (r >> 4) * 2 + (c >> 5), rr = r & 15, cc = c & 31, ob = rr * 64 + cc * 2; return st * 1024 + (ob ^ (((ob >> 9) & 1) << 5)); }
__host__ __device__ __forceinline__ void stage_rc(int b, int& R, int& C) { const int st = b / 1024, sb = b % 1024, swz = sb ^ (((sb >> 9) & 1) << 5); R = (st >> 1) * 16 + swz / 64; C = (st & 1) * 32 + (swz % 64) / 2; }
__host__ __device__ __forceinline__ int perm32(int rho) { const int n = rho >> 4, i = rho & 15; return 8 * (i >> 2) + 4 * n + (i & 3); }

struct Unit { int pm, pn; };
struct Gemm { const bf16_t* A; const bf16_t* Bt; int M, N, K; };

struct StaticOrder {
    int nM, nN, nwg, G, c;
    __host__ __device__ void init(int M, int N, int G_, int c_) { nM = M / BM; nN = N / BM; nwg = nM * nN; G = G_; c = c_; }
    __host__ __device__ bool next(int i, Unit& u) const {
        const long L = (long)i * G + c; if (L >= nwg) return false;
        int wgid = (int)L; { const int q = nwg / NXCD, r = nwg % NXCD, xcd = wgid % NXCD, off = wgid / NXCD; wgid = (xcd < r ? xcd * (q + 1) : r * (q + 1) + (xcd - r) * q) + off; }
        const int nig = WGM * nN, gid = wgid / nig, fm = gid * WGM, gsz = (nM - fm) < WGM ? (nM - fm) : WGM;
        u.pm = fm + ((wgid % nig) % gsz); u.pn = (wgid % nig) / gsz; return true;
    }
    __device__ __forceinline__ void a_ready(const Unit&) const {}
    __device__ __forceinline__ void done(const Unit&) const {}
};

__device__ __forceinline__ unsigned cvt_pk_bf16(float lo, float hi) { unsigned r; asm volatile("v_cvt_pk_bf16_f32 %0, %1, %2" : "=v"(r) : "v"(lo), "v"(hi)); return r; }
typedef float f32x2 __attribute__((ext_vector_type(2)));
__device__ __forceinline__ f32x2 gelu_pk(f32x2 v) {
    const f32x2 av = __builtin_elementwise_abs(v), d = av * 0.2316418882f + 1.0f;
    f32x2 t; t.x = __builtin_amdgcn_rcpf(d.x); t.y = __builtin_amdgcn_rcpf(d.y);
    f32x2 q = t * 0.5307027145f + (-0.7265760135f); q = q * t + 0.7107068705f; q = q * t + (-0.142248368f); q = q * t + 0.127414796f; q = q * t;
    const f32x2 s = (v * v) * (-0.72134752044f);
    f32x2 e; e.x = __builtin_amdgcn_exp2f(s.x); e.y = __builtin_amdgcn_exp2f(s.y);
    const f32x2 m = v * (q * e), r = v - m;
    f32x2 o; o.x = v.x < 0.f ? m.x : r.x; o.y = v.y < 0.f ? m.y : r.y; return o;
}

template <int ACT  > struct EpiBf16 {
    static constexpr bool PERM = true, AFTER_DRAIN = false; static_assert(ACT == 0 || ACT == 1, "EpiBf16: ACT is 0 (none) or 1 (gelu_pk)");
    bf16_t* O; int ldc; const float* bias; int split_cols; size_t split_stride; float scale0;
    __device__ __forceinline__ void operator()(const f32x4 (&acc)[2][2][4][2], const Unit& u, int wr, int wc, int fr, int fq) const {
        const int row0 = u.pm * BM + wr * 64 + fr; int colt = u.pn * BM; bf16_t* base = O;
        float sc = 1.f; if (split_cols) { const int t = colt / split_cols; base += (size_t)t * split_stride; colt -= t * split_cols; if (t == 0) sc = scale0; }
        const int col0 = colt + wc * 32 + 8 * fq, bcol0 = u.pn * BM + wc * 32 + 8 * fq;
        f32x4 bv[2][2];
#pragma unroll
        for (int bj = 0; bj < 2; ++bj)
#pragma unroll
            for (int n = 0; n < 2; ++n) bv[bj][n] = bias ? *(const f32x4*)(bias + bcol0 + bj * HALF + 4 * n) : (f32x4){0.f, 0.f, 0.f, 0.f};
#pragma unroll
        for (int ai = 0; ai < 2; ++ai)
#pragma unroll
            for (int m = 0; m < 4; ++m) { bf16_t* rowp = base + (size_t)(row0 + ai * HALF + m * 16) * ldc + col0;
#pragma unroll
                for (int bj = 0; bj < 2; ++bj) { f32x4 v0 = acc[ai][bj][m][0] + bv[bj][0], v1 = acc[ai][bj][m][1] + bv[bj][1];
                    if (ACT == 1) { f32x2 a = gelu_pk((f32x2){v0[0], v0[1]}), b = gelu_pk((f32x2){v0[2], v0[3]}), c = gelu_pk((f32x2){v1[0], v1[1]}), d = gelu_pk((f32x2){v1[2], v1[3]});
                        v0 = (f32x4){a.x, a.y, b.x, b.y}; v1 = (f32x4){c.x, c.y, d.x, d.y}; }
                    v0 = v0 * sc; v1 = v1 * sc; u32x4 w; w.x = cvt_pk_bf16(v0[0], v0[1]); w.y = cvt_pk_bf16(v0[2], v0[3]); w.z = cvt_pk_bf16(v1[0], v1[1]); w.w = cvt_pk_bf16(v1[2], v1[3]);
                    *(u32x4*)(rowp + bj * HALF) = w; } }
    }
};

template <class Epi, class Sched, bool ALIGN_EPI = false, bool SP2 = false>
__device__ __forceinline__ void gemm_phase(PG8_LAS unsigned char* lds, const Gemm g, const Sched& S, const Epi& E) {
    const int tid = threadIdx.x, wid = __builtin_amdgcn_readfirstlane(tid >> 6), lane = tid & 63, wr = wid >> 2, wc = wid & 3, fr = lane & 15, fq = lane >> 4;
    const int K = g.K, nt = K / BK;
    unsigned voffA[2], voffB[2];
#pragma unroll
    for (int i = 0; i < 2; ++i) { int R, C; stage_rc(tid * 16 + i * 8192, R, C); const int Rb = Epi::PERM ? ((R & ~31) + perm32(R & 31)) : R;
        voffA[i] = (unsigned)(R * K + C) * 2u; voffB[i] = (unsigned)(Rb * K + C) * 2u; }
    const size_t kstep = (size_t)(BK * 2);
    const size_t hstep = (size_t)HALF * K * 2;
    const size_t tstep = 2 * hstep;
    const unsigned ldsw = (unsigned)wid * 1024u;
    const int aoff = lds_byte(wr * 64 + fr, fq * 8), boff = lds_byte(wc * 32 + fr, fq * 8);
#define PG8_SA(b, h) (((b) * 2 + (h)) * HTB)
#define PG8_SB(b, h) ((4 + (b) * 2 + (h)) * HTB)
#define PG8_STAGE(bufoff, gbase, voff) do { _Pragma("unroll") for (int _i = 0; _i < 2; ++_i) \
        __builtin_amdgcn_global_load_lds((const unsigned*)((const char*)(gbase) + (voff)[_i]), (PG8_LAS unsigned*)(lds + (bufoff) + ldsw + _i * 8192), 16, 0, 0); } while (0)
#define PG8_LDA(dst, b, h) do { _Pragma("unroll") for (int m = 0; m < 4; ++m) _Pragma("unroll") for (int k = 0; k < 2; ++k) dst[m][k] = *(const PG8_LAS bf16x8*)(lds + PG8_SA(b, h) + aoff + m * 2048 + k * 1024); } while (0)
#define PG8_LDB(dst, b, h) do { _Pragma("unroll") for (int n = 0; n < 2; ++n) _Pragma("unroll") for (int k = 0; k < 2; ++k) dst[n][k] = *(const PG8_LAS bf16x8*)(lds + PG8_SB(b, h) + boff + n * 2048 + k * 1024); } while (0)
#define PG8_MMA(ai, bj, At, Bt) do { __builtin_amdgcn_s_setprio(1); _Pragma("unroll") for (int m = 0; m < 4; ++m) _Pragma("unroll") for (int n = 0; n < 2; ++n) _Pragma("unroll") for (int k = 0; k < 2; ++k) \
        acc[ai][bj][m][n] = __builtin_amdgcn_mfma_f32_16x16x32_bf16(Bt[n][k], At[m][k], acc[ai][bj][m][n], 0, 0, 0); __builtin_amdgcn_s_setprio(0); } while (0)
#define PG8_WAIT_V(n) asm volatile("s_waitcnt vmcnt(" #n ")" ::: "memory")
#define PG8_WAIT_L(n) asm volatile("s_waitcnt lgkmcnt(" #n ")" ::: "memory")
#define PG8_BAR __builtin_amdgcn_s_barrier()
#define PG8_SCHED __builtin_amdgcn_sched_barrier(0)
    Unit cur, nxt; int ui = 0;
    if (!S.next(0, cur)) return;
    f32x4 acc[2][2][4][2];
#pragma unroll
    for (int a = 0; a < 2; ++a)
#pragma unroll
        for (int b = 0; b < 2; ++b)
#pragma unroll
            for (int m = 0; m < 4; ++m)
#pragma unroll
                for (int n = 0; n < 2; ++n) acc[a][b][m][n] = (f32x4){0.f, 0.f, 0.f, 0.f};
    bf16x8 At[4][2], B0[2][2], B1[2][2];
    const char* cA = (const char*)g.A + (size_t)cur.pm * tstep; const char* cB = (const char*)g.Bt + (size_t)cur.pn * tstep;
    S.a_ready(cur);
    if constexpr (SP2) {
        PG8_STAGE(PG8_SB(0, 0), cB, voffB); PG8_STAGE(PG8_SB(0, 1), cB + hstep, voffB); PG8_STAGE(PG8_SA(0, 0), cA, voffA); PG8_STAGE(PG8_SA(0, 1), cA + hstep, voffA);
        if (wr == 1) PG8_BAR;
        PG8_WAIT_V(2); PG8_BAR;
        PG8_STAGE(PG8_SB(1, 0), cB + kstep, voffB); PG8_STAGE(PG8_SA(1, 0), cA + kstep, voffA); PG8_STAGE(PG8_SB(1, 1), cB + hstep + kstep, voffB);
        PG8_WAIT_V(6); PG8_BAR;
    } else {
        PG8_STAGE(PG8_SB(0, 0), cB, voffB); PG8_STAGE(PG8_SA(0, 0), cA, voffA); PG8_STAGE(PG8_SB(0, 1), cB + hstep, voffB); PG8_STAGE(PG8_SA(0, 1), cA + hstep, voffA);
        if (wr == 1) PG8_BAR;
        PG8_WAIT_V(4); PG8_BAR;
        PG8_STAGE(PG8_SB(1, 0), cB + kstep, voffB); PG8_STAGE(PG8_SA(1, 0), cA + kstep, voffA); PG8_STAGE(PG8_SB(1, 1), cB + hstep + kstep, voffB);
        PG8_WAIT_V(6); PG8_BAR;
    }
    for (;;) {
        const bool has_next = S.next(ui + 1, nxt);
        const char* nA = has_next ? (const char*)g.A + (size_t)nxt.pm * tstep : cA; const char* nB = has_next ? (const char*)g.Bt + (size_t)nxt.pn * tstep : cB;
        for (int t = 0; t < nt; t += 2) {
            const bool last = (t == nt - 2);
            const char* a1 = cA + (size_t)(t + 1) * kstep;
            const char* a2 = last ? nA : cA + (size_t)(t + 2) * kstep; const char* b2 = last ? nB : cB + (size_t)(t + 2) * kstep;
            const char* a3 = a2 + kstep; const char* b3 = b2 + kstep;
            if (last && has_next) S.a_ready(nxt);
            if constexpr (SP2) {
            PG8_LDB(B0, 0, 0); PG8_LDB(B1, 0, 1); PG8_SCHED; PG8_LDA(At, 0, 0); PG8_STAGE(PG8_SA(1, 1), a1 + hstep, voffA);
            PG8_WAIT_V(8); PG8_WAIT_L(0); PG8_BAR; PG8_MMA(0, 0, At, B0); PG8_MMA(0, 1, At, B1); PG8_BAR; PG8_SCHED;
            PG8_LDA(At, 0, 1); PG8_STAGE(PG8_SB(0, 0), b2, voffB); PG8_STAGE(PG8_SB(0, 1), b2 + hstep, voffB); PG8_STAGE(PG8_SA(0, 0), a2, voffA);
            PG8_WAIT_V(8); PG8_WAIT_L(0); PG8_BAR; PG8_MMA(1, 0, At, B0); PG8_MMA(1, 1, At, B1); PG8_BAR; PG8_SCHED;
            PG8_LDB(B0, 1, 0); PG8_LDB(B1, 1, 1); PG8_SCHED; PG8_LDA(At, 1, 0); PG8_STAGE(PG8_SA(0, 1), a2 + hstep, voffA);
            PG8_WAIT_V(8); PG8_WAIT_L(0); PG8_BAR; PG8_MMA(0, 0, At, B0); PG8_MMA(0, 1, At, B1); PG8_BAR; PG8_SCHED;
            PG8_LDA(At, 1, 1); PG8_STAGE(PG8_SB(1, 0), b3, voffB); PG8_STAGE(PG8_SB(1, 1), b3 + hstep, voffB); PG8_STAGE(PG8_SA(1, 0), a3, voffA);
            PG8_WAIT_V(8); PG8_WAIT_L(0); PG8_BAR; PG8_MMA(1, 0, At, B0); PG8_MMA(1, 1, At, B1); PG8_BAR; PG8_SCHED;
            } else {
            PG8_LDB(B0, 0, 0); PG8_SCHED; PG8_LDA(At, 0, 0); PG8_STAGE(PG8_SA(1, 1), a1 + hstep, voffA);
            PG8_WAIT_L(8); PG8_BAR; PG8_WAIT_L(0); PG8_MMA(0, 0, At, B0); PG8_BAR; PG8_SCHED;
            PG8_LDB(B1, 0, 1); PG8_STAGE(PG8_SB(0, 0), b2, voffB);
            PG8_BAR; PG8_WAIT_L(0); PG8_MMA(0, 1, At, B1); PG8_BAR;
            PG8_LDA(At, 0, 1); PG8_STAGE(PG8_SA(0, 0), a2, voffA);
            PG8_BAR; PG8_WAIT_L(0); PG8_MMA(1, 0, At, B0); PG8_BAR; PG8_SCHED;
            PG8_STAGE(PG8_SB(0, 1), b2 + hstep, voffB);
            PG8_WAIT_V(6); PG8_BAR; PG8_MMA(1, 1, At, B1); PG8_BAR;
            PG8_LDB(B0, 1, 0); PG8_SCHED; PG8_LDA(At, 1, 0); PG8_STAGE(PG8_SA(0, 1), a2 + hstep, voffA);
            PG8_WAIT_L(8); PG8_BAR; PG8_WAIT_L(0); PG8_MMA(0, 0, At, B0); PG8_BAR; PG8_SCHED;
            PG8_LDB(B1, 1, 1); PG8_STAGE(PG8_SB(1, 0), b3, voffB);
            PG8_BAR; PG8_WAIT_L(0); PG8_MMA(0, 1, At, B1); PG8_BAR;
            PG8_LDA(At, 1, 1); PG8_STAGE(PG8_SA(1, 0), a3, voffA);
            PG8_BAR; PG8_WAIT_L(0); PG8_MMA(1, 0, At, B0); PG8_BAR; PG8_SCHED;
            PG8_STAGE(PG8_SB(1, 1), b3 + hstep, voffB);
            PG8_WAIT_V(6); PG8_BAR; PG8_MMA(1, 1, At, B1); PG8_BAR;
            }
        }
        if constexpr (ALIGN_EPI) { if (wr == 0) PG8_BAR; }
        if constexpr (!Epi::AFTER_DRAIN) { E(acc, cur, wr, wc, fr, fq); S.done(cur); }
        if (!has_next) break;
#pragma unroll
        for (int a = 0; a < 2; ++a)
#pragma unroll
            for (int b = 0; b < 2; ++b)
#pragma unroll
                for (int m = 0; m < 4; ++m)
#pragma unroll
                    for (int n = 0; n < 2; ++n) acc[a][b][m][n] = (f32x4){0.f, 0.f, 0.f, 0.f};
        cur = nxt; cA = nA; cB = nB; ++ui;
        if constexpr (ALIGN_EPI) { if (wr == 1) PG8_BAR; }
    }
    PG8_WAIT_V(0);
    if constexpr (!ALIGN_EPI) { if (wr == 0) PG8_BAR; }
    PG8_BAR;
    if constexpr (Epi::AFTER_DRAIN) { E.fused(acc, cur, wr, wc, fr, fq, lds, wid, lane); S.done(cur); }
#undef PG8_SA
#undef PG8_SB
#undef PG8_STAGE
#undef PG8_LDA
#undef PG8_LDB
#undef PG8_MMA
#undef PG8_WAIT_V
#undef PG8_WAIT_L
#undef PG8_BAR
#undef PG8_SCHED
}
}
#define GAS __attribute__((address_space(1)))
#define LAS __attribute__((address_space(3)))
typedef unsigned short bf16;
typedef unsigned v4u __attribute__((ext_vector_type(4)));
typedef float f32x4 __attribute__((ext_vector_type(4)));
typedef short bf16x8 __attribute__((ext_vector_type(8)));
typedef GAS unsigned gu32;
typedef GAS unsigned long long gu64;
#define RLX_AGENT __ATOMIC_RELAXED, __HIP_MEMORY_SCOPE_AGENT
#define LDS_WAIT() asm volatile("s_waitcnt lgkmcnt(0)" ::: "memory")
#define VM_WAIT() asm volatile("s_waitcnt vmcnt(0)" ::: "memory")
__device__ __forceinline__ unsigned long long rt() { return __builtin_amdgcn_s_memrealtime(); }
__device__ __forceinline__ unsigned f2bf(float f) { unsigned u = __builtin_bit_cast(unsigned, f); return (u + 0x7fffu + ((u >> 16) & 1u)) >> 16; }
__device__ __forceinline__ unsigned pk2(float lo, float hi) { return f2bf(lo) | (f2bf(hi) << 16); }

#define XB_TMO      128
#define XB_XCNT(j)  (256  + 64 * (j))
#define XB_XSUB(j)  (1280 + 64 * (j))
#define XB_XGEN(j)  (2304 + 64 * (j))
#define XB_TOP      3328
#define XB_TOPGEN   3392
#define XCD_BAR_WORDS 3456
#define XB_SPIN_CAP (1u << 20)

__device__ __forceinline__ unsigned xb_ld(unsigned* p)              { return __hip_atomic_load(p, __ATOMIC_RELAXED, __HIP_MEMORY_SCOPE_AGENT); }
__device__ __forceinline__ unsigned xb_add(unsigned* p, unsigned v) { return __hip_atomic_fetch_add(p, v, __ATOMIC_RELAXED, __HIP_MEMORY_SCOPE_AGENT); }
__device__ __forceinline__ unsigned xb_xcc_id() { return (unsigned)__builtin_amdgcn_s_getreg((3 << 11) | 20) & 0xFu; }
#define XB_SPIN(cond, bar) do { unsigned _sp = 0; while (cond) { __builtin_amdgcn_s_sleep(1); \
    if ((++_sp & 255u) == 0u) { if (xb_ld(&(bar)[XB_TMO])) break; if (_sp > XB_SPIN_CAP) { atomicAdd(&(bar)[XB_TMO], 1u); break; } } } } while (0)

struct XcdBarrier {
    unsigned* bar; unsigned x;
    volatile LAS unsigned* st;
};

__device__ __forceinline__ XcdBarrier xcd_barrier_post(unsigned* bar, volatile LAS unsigned* st) {
    XcdBarrier b; b.bar = bar; b.x = xb_xcc_id(); b.st = st;
    if (threadIdx.x == 0) (void)xb_add(&bar[XB_XCNT(b.x)], 1u);
    return b;
}
__device__ __forceinline__ void xcd_barrier_complete(unsigned* bar, unsigned x, unsigned& nloc, unsigned& nx) {
    const unsigned G = gridDim.x * gridDim.y * gridDim.z;
    unsigned sum, cnt, mine, sp = 0u;
    for (;;) {
        sum = 0u; cnt = 0u; mine = 0u;
#pragma unroll
        for (unsigned j = 0; j < 16; ++j) { const unsigned c = xb_ld(&bar[XB_XCNT(j)]); sum += c; cnt += (c > 0u) ? 1u : 0u; mine = (j == x) ? c : mine; }
        if (sum == G) break;
        __builtin_amdgcn_s_sleep(1);
        if ((++sp & 255u) == 0u) { if (xb_ld(&bar[XB_TMO])) break; if (sp > XB_SPIN_CAP) { atomicAdd(&bar[XB_TMO], 1u); break; } }
    }
    nloc = mine > 0u ? mine : 1u; nx = cnt > 0u ? cnt : 1u;
}

__device__ __forceinline__ void xcd_barrier(const XcdBarrier& b) {
    asm volatile("s_waitcnt vmcnt(0)" ::: "memory");
    __syncthreads();
    if (threadIdx.x == 0) {
        unsigned* bar = b.bar;
        __builtin_amdgcn_s_waitcnt(0);
        unsigned nloc = b.st[0], nx = b.st[1];
        if (nloc == 0u) { xcd_barrier_complete(bar, b.x, nloc, nx); b.st[0] = nloc; b.st[1] = nx; }
        const unsigned old = xb_add(&bar[XB_XSUB(b.x)], 1u);
        const unsigned gen = old / nloc;
        if (old + 1u == (gen + 1u) * nloc) {
            __builtin_amdgcn_fence(__ATOMIC_RELEASE, "agent");
            asm volatile("s_waitcnt vmcnt(0)" ::: "memory");
            const unsigned og = xb_add(&bar[XB_TOP], 1u);
            const unsigned tg = og / nx;
            if (og + 1u == (tg + 1u) * nx) xb_add(&bar[XB_TOPGEN], 1u);
            else XB_SPIN(xb_ld(&bar[XB_TOPGEN]) == tg, bar);
            __builtin_amdgcn_fence(__ATOMIC_ACQUIRE, "agent");
            xb_add(&bar[XB_XGEN(b.x)], 1u);
            asm volatile("s_waitcnt vmcnt(0)" ::: "memory");
        } else {
            XB_SPIN(xb_ld(&bar[XB_XGEN(b.x)]) == gen, bar);
            __builtin_amdgcn_fence(__ATOMIC_ACQUIRE, "agent");
            asm volatile("s_waitcnt vmcnt(0)" ::: "memory");
        }
    }
    __syncthreads();
}

constexpr int NWAVES = 8;
constexpr int BATCH = 2, T = 8192, DM = 1024, M = BATCH * T;
constexpr int N0 = 4096, N1 = 3072;
constexpr int EVEN_IN = 3908, ODD_IN = 2976;
constexpr float NORM_EPS = 1e-6f;
constexpr int C0_AQ = 0, C0_AK = 512, C0_AV = 1024, C0_AG = 1536, C0_BQ = 2048, C0_BK = 2304, C0_BV = 2560, C0_BG = 3072, C0_IQ = 3584, C0_IK = 3840, C0_IW = 3904;
constexpr int C1_CQ = 0, C1_CK = 512, C1_CV = 1024, C1_CG = 1536, C1_DCQ = 2048, C1_DCKV = 2304, C1_DKR = 2432, C1_DG = 2464;

constexpr size_t MiB = 1u << 20;
constexpr size_t WS_CTL = 0, CTL_ZERO_BYTES = 1 * MiB;
constexpr size_t WS_W0T = 1 * MiB;
constexpr size_t WS_WO0T = 9 * MiB;
constexpr size_t WS_W1T = 11 * MiB;
constexpr size_t WS_WUQT = 17 * MiB;
constexpr size_t WS_WUKVT = 17 * MiB + 512 * 1024;
constexpr size_t WS_WO1T = 18 * MiB;
constexpr size_t WS_ROPE = 20 * MiB;
constexpr size_t WS_MASK = 26 * MiB;
constexpr size_t WS_U = 42 * MiB;
constexpr size_t WS_A = 58 * MiB;
constexpr size_t WS_B = 90 * MiB;
constexpr size_t WS_QD = 186 * MiB;
constexpr size_t WS_KVX = 218 * MiB;
constexpr size_t WS_KROPE = 250 * MiB;
constexpr size_t WS_END = 256 * MiB;
constexpr int CW_TMO = 0, CW_CODE = 1, CW_BAR = 4096;

constexpr int RING_OFF = 0, RING_BYTES = 131072;
constexpr int LDSCTL_OFF = RING_BYTES, MISC_OFF = LDSCTL_OFF + 320, INFO_OFF = LDSCTL_OFF + 1024;
constexpr int LDS_BYTES = 147456;

typedef float f32x16 __attribute__((ext_vector_type(16)));
typedef short s16x4 __attribute__((ext_vector_type(4)));
typedef unsigned u32x2 __attribute__((ext_vector_type(2)));

__device__ __forceinline__ float bf2f(bf16 b) { return __builtin_bit_cast(float, (unsigned)b << 16); }
__device__ __forceinline__ float bflo(unsigned w) { return __builtin_bit_cast(float, w << 16); }
__device__ __forceinline__ float bfhi(unsigned w) { return __builtin_bit_cast(float, w & 0xffff0000u); }
__device__ __forceinline__ float wave_sum(float v) {
#pragma unroll
    for (int o = 1; o < 64; o <<= 1) v += __shfl_xor(v, o);
    return v;
}
__device__ __forceinline__ float silu(float g) { return g / (1.0f + __expf(-g)); }
__device__ __forceinline__ f32x4 mfma16(bf16x8 a, bf16x8 b, f32x4 c) { return __builtin_amdgcn_mfma_f32_16x16x32_bf16(a, b, c, 0, 0, 0); }
__device__ __forceinline__ f32x16 mfma32(bf16x8 a, bf16x8 b, f32x16 c) { return __builtin_amdgcn_mfma_f32_32x32x16_bf16(a, b, c, 0, 0, 0); }

struct EpiF32 {
    static constexpr bool PERM = false, AFTER_DRAIN = false;
    float* O; int ldc;
    __device__ __forceinline__ void operator()(const pg8::f32x4 (&acc)[2][2][4][2], const pg8::Unit& u, int wr, int wc, int fr, int fq) const {
        const int row0 = u.pm * 256 + wr * 64 + fr, col0 = u.pn * 256 + wc * 32 + 4 * fq;
#pragma unroll
        for (int ai = 0; ai < 2; ++ai)
#pragma unroll
            for (int m = 0; m < 4; ++m) { float* rowp = O + (size_t)(row0 + ai * 128 + m * 16) * ldc + col0;
#pragma unroll
                for (int bj = 0; bj < 2; ++bj)
#pragma unroll
                    for (int n = 0; n < 2; ++n) *(pg8::f32x4*)(rowp + bj * 128 + n * 16) = acc[ai][bj][m][n]; }
    }
};

struct Frame {
    LAS unsigned char* lds;
    volatile LAS unsigned* MISC;
    gu32* ctl;
    int tid, lane, wave;
    int vcu, G;
    unsigned char* ws;
    const float* x; const int* pos; const float* pre_norm; const float* post_norm;
    const float *w_in_even, *w_out_even, *w_in_odd, *diff_lambda, *diff_subln, *q_norm, *kv_norm, *w_uq, *w_ukv, *w_out_odd;
    float* out;
};

__device__ __forceinline__ void sincos_acc(float ang, float& s_out, float& c_out) {
    const double a = (double)ang;
    const double k = __builtin_rint(a * 0.63661977236758134308);
    double r = __builtin_fma(-k, 1.57079632679489655800, a);
    r = __builtin_fma(-k, 6.12323399573676603587e-17, r);
    const float x = (float)r, x2 = x * x;
    const float s = x + x * x2 * (-1.6666667163e-1f + x2 * (8.3333337680e-3f + x2 * (-1.9841270114e-4f + x2 * 2.7557314297e-6f)));
    const float c = 1.0f - 0.5f * x2 + x2 * x2 * (4.1666667908e-2f + x2 * (-1.3888889225e-3f + x2 * (2.4801587642e-5f - x2 * 2.7557314297e-7f)));
    const int q = ((int)k) & 3;
    s_out = (q == 0) ? s : (q == 1) ? c : (q == 2) ? -s : -c;
    c_out = (q == 0) ? c : (q == 1) ? -s : (q == 2) ? -c : s;
}

template <int MAP>
__device__ __forceinline__ int src_col(int n, int Nsrc) {
    if (MAP == 1) { if (n < 2048) return n; if (n < 3584) return n + 324; if (n < 3908) return n - 1536; return -1; }
    return n < Nsrc ? n : -1;
}
template <int MAP>
__device__ __forceinline__ void p0_transpose_item(const float* W, int K, int Nsrc, int Ndst, bf16* WT, LAS float* scr, int item, int lane) {
    const int nblk = Ndst / 32, kb = item / nblk, nb = item % nblk, k0 = 64 * kb, n0 = 32 * nb;
    const int sc = src_col<MAP>(n0 + (lane & 31), Nsrc);
#pragma unroll 8
    for (int i = 0; i < 32; ++i) { const int kk = 2 * i + (lane >> 5); scr[kk * 33 + (lane & 31)] = sc >= 0 ? W[(size_t)(k0 + kk) * Nsrc + sc] : 0.0f; }
    LDS_WAIT(); asm volatile("" ::: "memory");
    const int c = lane & 7;
#pragma unroll
    for (int j = 0; j < 4; ++j) { const int n = (lane >> 3) + 8 * j; const LAS float* s = scr + (8 * c) * 33 + n;
        v4u o; o.x = pk2(s[0 * 33], s[1 * 33]); o.y = pk2(s[2 * 33], s[3 * 33]); o.z = pk2(s[4 * 33], s[5 * 33]); o.w = pk2(s[6 * 33], s[7 * 33]);
        *(GAS v4u*)(WT + (size_t)(n0 + n) * K + k0 + 8 * c) = o; }
    LDS_WAIT(); asm volatile("" ::: "memory");
}
__device__ __forceinline__ void rms_row_to_bf16(const float* xrow, const float* gain, bf16* orow, int lane) {
    const GAS f32x4* xr = (const GAS f32x4*)xrow + lane; const GAS f32x4* gr = (const GAS f32x4*)gain + lane;
    f32x4 v[4]; float s = 0.f;
#pragma unroll
    for (int j = 0; j < 4; ++j) { v[j] = xr[64 * j]; s += (v[j].x * v[j].x + v[j].y * v[j].y) + (v[j].z * v[j].z + v[j].w * v[j].w); }
    const float r = 1.0f / sqrtf(wave_sum(s) * (1.f / DM) + NORM_EPS);
    GAS unsigned long long* o8 = (GAS unsigned long long*)orow + lane;
#pragma unroll
    for (int j = 0; j < 4; ++j) { const f32x4 g = gr[64 * j];
        o8[64 * j] = (unsigned long long)pk2(v[j].x * r * g.x, v[j].y * r * g.y) | ((unsigned long long)pk2(v[j].z * r * g.z, v[j].w * r * g.w) << 32); }
}

__device__ __forceinline__ void p0_prologue(Frame& F) {
    LAS float* scr = (LAS float*)(F.lds + RING_OFF + F.wave * 16384);
    const int gw = F.vcu * NWAVES + F.wave, NGW = F.G * NWAVES;
    constexpr int I_W0 = (DM / 64) * (N0 / 32), I_WO = (DM / 64) * (DM / 32), I_W1 = (DM / 64) * (N1 / 32), I_UQ = (256 / 64) * (768 / 32), I_UKV = (128 / 64) * (1024 / 32);
    constexpr int NITEMS = I_W0 + I_WO + I_W1 + I_UQ + I_UKV + I_WO;
    for (int it = gw; it < NITEMS; it += NGW) {
        int r = it;
        if (r < I_W0) { p0_transpose_item<1>(F.w_in_even, DM, EVEN_IN, N0, (bf16*)(F.ws + WS_W0T), scr, r, F.lane); continue; } r -= I_W0;
        if (r < I_WO) { p0_transpose_item<0>(F.w_out_even, DM, DM, DM, (bf16*)(F.ws + WS_WO0T), scr, r, F.lane); continue; } r -= I_WO;
        if (r < I_W1) { p0_transpose_item<0>(F.w_in_odd, DM, ODD_IN, N1, (bf16*)(F.ws + WS_W1T), scr, r, F.lane); continue; } r -= I_W1;
        if (r < I_UQ) { p0_transpose_item<0>(F.w_uq, 256, 768, 768, (bf16*)(F.ws + WS_WUQT), scr, r, F.lane); continue; } r -= I_UQ;
        if (r < I_UKV) { p0_transpose_item<0>(F.w_ukv, 128, 1024, 1024, (bf16*)(F.ws + WS_WUKVT), scr, r, F.lane); continue; } r -= I_UKV;
        p0_transpose_item<0>(F.w_out_odd, DM, DM, DM, (bf16*)(F.ws + WS_WO1T), scr, r, F.lane);
    }
    {
        float* cosB = (float*)(F.ws + WS_ROPE); float* sinB = cosB + (size_t)M * 32; float* cosD = sinB + (size_t)M * 32; float* sinD = cosD + (size_t)M * 16;
        const int gt = F.vcu * (NWAVES * 64) + F.tid, NGT = F.G * NWAVES * 64;
        for (int e = gt; e < M * 48; e += NGT) {
            const int t = e / 48, i = e % 48;
            const float p = (float)F.pos[t];
            if (i < 32) { const float inv = (float)::exp2(-(double)i * (13.287712379549449 / 32.0)); float s, c; sincos_acc(p * inv, s, c); cosB[(size_t)t * 32 + i] = c; sinB[(size_t)t * 32 + i] = s; }
            else { const int ii = i - 32; const float inv = (float)::exp2(-(double)ii * (13.287712379549449 / 16.0)); float s, c; sincos_acc(p * inv, s, c); cosD[(size_t)t * 16 + ii] = c; sinD[(size_t)t * 16 + ii] = s; }
        }
    }
    for (int m = gw; m < M; m += NGW) rms_row_to_bf16(F.x + (size_t)m * DM, F.pre_norm, (bf16*)(F.ws + WS_A) + (size_t)m * DM, F.lane);
}

template <bool NEXT>
__device__ __forceinline__ void post_norm_rows(Frame& F, const float* xin, const float* mbuf, const float* gpost, const float* gpre, float* xout, bf16* hn) {
    const int gw = F.vcu * NWAVES + F.wave, NGW = F.G * NWAVES, lane = F.lane;
    for (int row = gw; row < M; row += NGW) {
        const GAS f32x4* mr = (const GAS f32x4*)(mbuf + (size_t)row * DM) + lane; const GAS f32x4* xr = (const GAS f32x4*)(xin + (size_t)row * DM) + lane;
        const GAS f32x4* gp = (const GAS f32x4*)gpost + lane;
        f32x4 mv[4], xv[4]; float s = 0.f;
#pragma unroll
        for (int j = 0; j < 4; ++j) { mv[j] = mr[64 * j]; xv[j] = xr[64 * j]; s += (mv[j].x * mv[j].x + mv[j].y * mv[j].y) + (mv[j].z * mv[j].z + mv[j].w * mv[j].w); }
        const float r = 1.0f / sqrtf(wave_sum(s) * (1.f / DM) + NORM_EPS);
        float s2 = 0.f;
#pragma unroll
        for (int j = 0; j < 4; ++j) { const f32x4 g = gp[64 * j]; xv[j] = xv[j] + (mv[j] * r) * g; s2 += (xv[j].x * xv[j].x + xv[j].y * xv[j].y) + (xv[j].z * xv[j].z + xv[j].w * xv[j].w); }
        GAS f32x4* xo = (GAS f32x4*)(xout + (size_t)row * DM) + lane;
#pragma unroll
        for (int j = 0; j < 4; ++j) xo[64 * j] = xv[j];
        if (NEXT) {
            const float r2 = 1.0f / sqrtf(wave_sum(s2) * (1.f / DM) + NORM_EPS);
            const GAS f32x4* gq = (const GAS f32x4*)gpre + lane; GAS unsigned long long* o8 = (GAS unsigned long long*)(hn + (size_t)row * DM) + lane;
#pragma unroll
            for (int j = 0; j < 4; ++j) { const f32x4 g = gq[64 * j];
                o8[64 * j] = (unsigned long long)pk2(xv[j].x * r2 * g.x, xv[j].y * r2 * g.y) | ((unsigned long long)pk2(xv[j].z * r2 * g.z, xv[j].w * r2 * g.w) << 32); }
        }
    }
}

__device__ __forceinline__ float ret_lg2_precise(int h) {
    return h == 0 ? -0.04580368961312479f : h == 1 ? -0.02272007650008353f : h == 2 ? -0.011315313227834146f : -0.005646563141142063f; }

__device__ __forceinline__ void ret_rot8(const bf16* src, const float* cosB, const float* sinB, size_t trow, int hcol, int d0, float scale, float (&o1)[8], float (&o2)[8]) {
    const bf16* kp = src + trow * N0 + hcol;
    const v4u x1 = *(const GAS v4u*)(kp + d0), x2 = *(const GAS v4u*)(kp + 32 + d0);
    const GAS f32x4* cp = (const GAS f32x4*)(cosB + trow * 32 + d0); const GAS f32x4* sp = (const GAS f32x4*)(sinB + trow * 32 + d0);
    const f32x4 c0 = cp[0], c1 = cp[1], s0 = sp[0], s1 = sp[1];
    const float co[8] = {c0.x, c0.y, c0.z, c0.w, c1.x, c1.y, c1.z, c1.w}, si[8] = {s0.x, s0.y, s0.z, s0.w, s1.x, s1.y, s1.z, s1.w};
    const unsigned w1[4] = {x1.x, x1.y, x1.z, x1.w}, w2[4] = {x2.x, x2.y, x2.z, x2.w};
#pragma unroll
    for (int e = 0; e < 8; ++e) {
        const float a = (e & 1) ? bfhi(w1[e >> 1]) : bflo(w1[e >> 1]), b = (e & 1) ? bfhi(w2[e >> 1]) : bflo(w2[e >> 1]);
        o1[e] = (a * co[e] - b * si[e]) * scale; o2[e] = (a * si[e] + b * co[e]) * scale;
    }
}

__device__ __forceinline__ void ret_u_item(Frame& F, int item) {
    int tid_o = F.tid; asm volatile("" : "+v"(tid_o));
    const int n = item & 63, h = (item >> 6) & 3, b = item >> 8, tid = tid_o, lane = tid & 63, wave = F.wave;
    LAS bf16* KT = (LAS bf16*)(F.lds + RING_OFF); LAS bf16* VT = KT + 64 * 136;
    const bf16* P = (const bf16*)(F.ws + WS_B);
    const float* cosB = (const float*)(F.ws + WS_ROPE); const float* sinB = cosB + (size_t)M * 32;
    const float lg2 = ret_lg2_precise(h);
    {
        const int j = tid >> 2, d0 = (tid & 3) * 8; const size_t trow = (size_t)b * T + n * 128 + j;
        float o1[8], o2[8]; ret_rot8(P, cosB, sinB, trow, C0_BK + h * 64, d0, 0.125f * __builtin_amdgcn_exp2f((float)(127 - j) * lg2), o1, o2);
#pragma unroll
        for (int e = 0; e < 8; ++e) { KT[(d0 + e) * 136 + j] = (bf16)f2bf(o1[e]); KT[(32 + d0 + e) * 136 + j] = (bf16)f2bf(o2[e]); }
    }
#pragma unroll
    for (int i = 0; i < 4; ++i) {
        const int p = tid + 512 * i, j = p >> 4, c = (p & 15) * 8; const size_t trow = (size_t)b * T + n * 128 + j;
        const v4u x = *(const GAS v4u*)(P + trow * N0 + C0_BV + h * 128 + c); const unsigned w[4] = {x.x, x.y, x.z, x.w};
#pragma unroll
        for (int e = 0; e < 8; ++e) VT[(c + e) * 136 + j] = (bf16)((e & 1) ? (w[e >> 1] >> 16) : (w[e >> 1] & 0xffffu));
    }
    __syncthreads();
    const int dt = wave & 3, et0 = (wave >> 2) * 4, fr = lane & 15, fq = lane >> 4;
    f32x4 acc[4];
#pragma unroll
    for (int i = 0; i < 4; ++i) acc[i] = (f32x4){0.f, 0.f, 0.f, 0.f};
#pragma unroll
    for (int ks = 0; ks < 4; ++ks) {
        const bf16x8 a = *(const LAS bf16x8*)(KT + (16 * dt + fr) * 136 + 32 * ks + 8 * fq);
#pragma unroll
        for (int nt = 0; nt < 4; ++nt) { const bf16x8 bb = *(const LAS bf16x8*)(VT + (16 * (et0 + nt) + fr) * 136 + 32 * ks + 8 * fq); acc[nt] = mfma16(a, bb, acc[nt]); }
    }
    float* U = (float*)(F.ws + WS_U) + (size_t)((b * 4 + h) * 64 + n) * 8192;
#pragma unroll
    for (int nt = 0; nt < 4; ++nt)
#pragma unroll
        for (int r = 0; r < 4; ++r) U[(16 * dt + 4 * fq + r) * 128 + 16 * (et0 + nt) + fr] = acc[nt][r];
    __syncthreads();
}

__device__ __forceinline__ void ret_scan(Frame& F) {
    const int gt = F.vcu * (NWAVES * 64) + F.tid, NGT = F.G * NWAVES * 64;
    for (int e = gt; e < 8 * 8192; e += NGT) {
        const int bh = e >> 13, de = e & 8191, h = bh & 3;
        const float gch = __builtin_amdgcn_exp2f(128.0f * ret_lg2_precise(h));
        float* U = (float*)(F.ws + WS_U) + (size_t)bh * 64 * 8192 + de;
        float S = 0.f;
        for (int n0 = 0; n0 < 64; n0 += 8) {
            float v[8];
#pragma unroll
            for (int k = 0; k < 8; ++k) v[k] = U[(size_t)(n0 + k) * 8192];
#pragma unroll
            for (int k = 0; k < 8; ++k) { U[(size_t)(n0 + k) * 8192] = S; S = gch * S + v[k]; }
        }
    }
}

__device__ __forceinline__ void ret_out_item(Frame& F, int item) {
    int tid_o = F.tid; asm volatile("" : "+v"(tid_o));
    const int n = item & 63, h = (item >> 6) & 3, b = item >> 8, tid = tid_o, lane = tid & 63, wave = F.wave;
    LAS bf16* Qs = (LAS bf16*)(F.lds + RING_OFF); LAS bf16* Ks = Qs + 128 * 72; LAS bf16* VT = Ks + 128 * 72; LAS bf16* ST = VT + 128 * 136; LAS bf16* Ps = ST + 128 * 72;
    const bf16* P = (const bf16*)(F.ws + WS_B);
    const float* cosB = (const float*)(F.ws + WS_ROPE); const float* sinB = cosB + (size_t)M * 32;
    const float lg2 = ret_lg2_precise(h);
    {
        const int j = tid >> 2, d0 = (tid & 3) * 8; const size_t trow = (size_t)b * T + n * 128 + j;
        float o1[8], o2[8];
        ret_rot8(P, cosB, sinB, trow, C0_BQ + h * 64, d0, 1.0f, o1, o2);
        *(LAS v4u*)(Qs + j * 72 + d0) = (v4u){pk2(o1[0], o1[1]), pk2(o1[2], o1[3]), pk2(o1[4], o1[5]), pk2(o1[6], o1[7])};
        *(LAS v4u*)(Qs + j * 72 + 32 + d0) = (v4u){pk2(o2[0], o2[1]), pk2(o2[2], o2[3]), pk2(o2[4], o2[5]), pk2(o2[6], o2[7])};
        ret_rot8(P, cosB, sinB, trow, C0_BK + h * 64, d0, 0.125f, o1, o2);
        *(LAS v4u*)(Ks + j * 72 + d0) = (v4u){pk2(o1[0], o1[1]), pk2(o1[2], o1[3]), pk2(o1[4], o1[5]), pk2(o1[6], o1[7])};
        *(LAS v4u*)(Ks + j * 72 + 32 + d0) = (v4u){pk2(o2[0], o2[1]), pk2(o2[2], o2[3]), pk2(o2[4], o2[5]), pk2(o2[6], o2[7])};
    }
#pragma unroll
    for (int i = 0; i < 4; ++i) {
        const int p = tid + 512 * i, j = p >> 4, c = (p & 15) * 8; const size_t trow = (size_t)b * T + n * 128 + j;
        const v4u x = *(const GAS v4u*)(P + trow * N0 + C0_BV + h * 128 + c); const unsigned w[4] = {x.x, x.y, x.z, x.w};
#pragma unroll
        for (int e = 0; e < 8; ++e) VT[(c + e) * 136 + j] = (bf16)((e & 1) ? (w[e >> 1] >> 16) : (w[e >> 1] & 0xffffu));
    }
    {
        const float* U = (const float*)(F.ws + WS_U) + (size_t)((b * 4 + h) * 64 + n) * 8192;
#pragma unroll
        for (int i = 0; i < 4; ++i) {
            const int idx = tid + 512 * i, d = idx >> 5, e4 = (idx & 31) * 4;
            const f32x4 sv = *(const GAS f32x4*)(U + d * 128 + e4);
            ST[(e4 + 0) * 72 + d] = (bf16)f2bf(sv.x); ST[(e4 + 1) * 72 + d] = (bf16)f2bf(sv.y); ST[(e4 + 2) * 72 + d] = (bf16)f2bf(sv.z); ST[(e4 + 3) * 72 + d] = (bf16)f2bf(sv.w);
        }
    }
    __syncthreads();
    const int i0 = 16 * wave, fr = lane & 15, fq = lane >> 4;
    bf16x8 aq[2];
#pragma unroll
    for (int ks = 0; ks < 2; ++ks) aq[ks] = *(const LAS bf16x8*)(Qs + (i0 + fr) * 72 + 32 * ks + 8 * fq);
#pragma unroll
    for (int jt = 0; jt < 8; ++jt) {
        f32x4 acc = (f32x4){0.f, 0.f, 0.f, 0.f};
#pragma unroll
        for (int ks = 0; ks < 2; ++ks) { const bf16x8 bb = *(const LAS bf16x8*)(Ks + (16 * jt + fr) * 72 + 32 * ks + 8 * fq); acc = mfma16(aq[ks], bb, acc); }
#pragma unroll
        for (int r = 0; r < 4; ++r) { const int i = i0 + 4 * fq + r, j = 16 * jt + fr;
            const float dcy = (i >= j) ? __builtin_amdgcn_exp2f((float)(i - j) * lg2) : 0.f; Ps[i * 136 + j] = (bf16)f2bf(acc[r] * dcy); }
    }
    __syncthreads();
    f32x4 oi[8], oc[8];
#pragma unroll
    for (int et = 0; et < 8; ++et) { oi[et] = (f32x4){0.f, 0.f, 0.f, 0.f}; oc[et] = (f32x4){0.f, 0.f, 0.f, 0.f}; }
#pragma unroll
    for (int ks = 0; ks < 4; ++ks) {
        const bf16x8 ap = *(const LAS bf16x8*)(Ps + (i0 + fr) * 136 + 32 * ks + 8 * fq);
#pragma unroll
        for (int et = 0; et < 8; ++et) { const bf16x8 bb = *(const LAS bf16x8*)(VT + (16 * et + fr) * 136 + 32 * ks + 8 * fq); oi[et] = mfma16(ap, bb, oi[et]); }
    }
#pragma unroll
    for (int ks = 0; ks < 2; ++ks)
#pragma unroll
        for (int et = 0; et < 8; ++et) { const bf16x8 bb = *(const LAS bf16x8*)(ST + (16 * et + fr) * 72 + 32 * ks + 8 * fq); oc[et] = mfma16(aq[ks], bb, oc[et]); }
    bf16* MIX = (bf16*)(F.ws + WS_A);
#pragma unroll
    for (int r = 0; r < 4; ++r) {
        const int i = i0 + 4 * fq + r; const float xi = __builtin_amdgcn_exp2f((float)(i + 1) * lg2);
        float v[8]; float s = 0.f;
#pragma unroll
        for (int et = 0; et < 8; ++et) { v[et] = oi[et][r] + xi * oc[et][r]; s += v[et]; }
        s += __shfl_xor(s, 1); s += __shfl_xor(s, 2); s += __shfl_xor(s, 4); s += __shfl_xor(s, 8);
        const float mu = s * (1.f / 128.f); float q = 0.f;
#pragma unroll
        for (int et = 0; et < 8; ++et) { v[et] -= mu; q += v[et] * v[et]; }
        q += __shfl_xor(q, 1); q += __shfl_xor(q, 2); q += __shfl_xor(q, 4); q += __shfl_xor(q, 8);
        const float rstd = 1.0f / sqrtf(q * (1.f / 128.f) + NORM_EPS);
        const size_t trow = (size_t)b * T + n * 128 + i;
#pragma unroll
        for (int et = 0; et < 8; ++et) { const int e = 16 * et + fr; const float g = bf2f(P[trow * N0 + C0_BG + h * 128 + e]);
            MIX[trow * DM + 512 + h * 128 + e] = (bf16)f2bf(v[et] * rstd * silu(g)); }
    }
    __syncthreads();
}

template <int PASS>
__device__ __forceinline__ void idx_pass(const bf16x8 (&qa)[4][4], const LAS f32x4* wtab, const bf16* Kb, int g, LAS unsigned* hist, LAS unsigned* info, unsigned* maskrow, int wave, int lane) {
    const int r = lane & 31, hh = lane >> 5, ntile = g + 1;
    bf16x8 kb[4];
    int kt = wave;
    const unsigned klane = (unsigned)(r * N0 + 8 * hh);
    if (kt < ntile) { const bf16* kp = Kb + (size_t)(32 * kt) * N0;
#pragma unroll
        for (int ks = 0; ks < 4; ++ks) kb[ks] = *(const GAS bf16x8*)(kp + klane + 16 * ks); }
    for (; kt < ntile; kt += 8) {
        bf16x8 kn[4];
        if (kt + 8 < ntile) { const bf16* kp = Kb + (size_t)(32 * (kt + 8)) * N0;
#pragma unroll
            for (int ks = 0; ks < 4; ++ks) kn[ks] = *(const GAS bf16x8*)(kp + klane + 16 * ks); }
        else {
#pragma unroll
            for (int ks = 0; ks < 4; ++ks) kn[ks] = kb[ks]; }
        const int s = 32 * kt + r; const bool diag = (kt == g);
        unsigned word = 0u;
#pragma unroll
        for (int m = 0; m < 4; ++m) {
            f32x16 acc;
#pragma unroll
            for (int q = 0; q < 16; ++q) acc[q] = 0.f;
#pragma unroll
            for (int ks = 0; ks < 4; ++ks) acc = mfma32(qa[m][ks], kb[ks], acc);
#pragma unroll
            for (int i = 0; i < 4; ++i) {
                const f32x4 w4 = wtab[8 * m + 4 * hh + i];
                float sc = __builtin_fmaf(w4.x, __builtin_fmaxf(acc[i], 0.f), 0.0f);
                sc = __builtin_fmaf(w4.y, __builtin_fmaxf(acc[4 + i], 0.f), sc);
                sc = __builtin_fmaf(w4.z, __builtin_fmaxf(acc[8 + i], 0.f), sc);
                sc = __builtin_fmaf(w4.w, __builtin_fmaxf(acc[12 + i], 0.f), sc);
                const unsigned u = __builtin_bit_cast(unsigned, sc);
                unsigned key = u ^ ((unsigned)((int)u >> 31) | 0x80000000u);
                key = (key & 0xFFFFE000u) | (unsigned)(8191 - s);
                const int row = 8 * m + 4 * hh + i;
                const bool valid = !diag || (r <= row);
                if (PASS == 1) { if (valid) { const unsigned bin = key >> 21; __hip_atomic_fetch_add(hist + row * 1024 + (bin >> 1), 1u << ((bin & 1u) * 16u), __ATOMIC_RELAXED, __HIP_MEMORY_SCOPE_WORKGROUP); } }
                if (PASS == 2) { if (valid && (key >> 21) == info[row]) { const unsigned bin = (key >> 10) & 2047u; __hip_atomic_fetch_add(hist + row * 1024 + (bin >> 1), 1u << ((bin & 1u) * 16u), __ATOMIC_RELAXED, __HIP_MEMORY_SCOPE_WORKGROUP); } }
                if (PASS == 3) { if (valid && (key >> 10) == info[row]) { const unsigned bin = key & 1023u; __hip_atomic_fetch_add(hist + row * 1024 + (bin >> 1), 1u << ((bin & 1u) * 16u), __ATOMIC_RELAXED, __HIP_MEMORY_SCOPE_WORKGROUP); } }
#ifdef DBG_SEL_ALL
                if (PASS == 4) { const bool sel = valid; word |= (sel ? 1u : 0u) << row; }
#else
                if (PASS == 4) { const bool sel = valid && (key >= info[row]); word |= (sel ? 1u : 0u) << row; }
#endif
            }
            __builtin_amdgcn_sched_barrier(0);
        }
        if (PASS == 4) { const unsigned other = (unsigned)__shfl_xor((int)word, 32); word |= other; if (hh == 0) maskrow[s] = word; }
#pragma unroll
        for (int ks = 0; ks < 4; ++ks) kb[ks] = kn[ks];
    }
}

template <int L>
__device__ __forceinline__ void idx_scan(LAS unsigned* hist, LAS unsigned* info, LAS unsigned* need, int wave, int lane) {
    constexpr int NB = (L == 3) ? 1024 : 2048, BPL = NB / 64, WPL = BPL / 2;
#pragma unroll 1
    for (int rr = 0; rr < 4; ++rr) {
        const int row = 4 * wave + rr;
        const LAS unsigned* hp = hist + row * 1024 + lane * WPL;
        unsigned wds[WPL]; unsigned cnt = 0u;
#pragma unroll
        for (int k = 0; k < WPL; ++k) { wds[k] = hp[k]; cnt += (wds[k] & 0xffffu) + (wds[k] >> 16); }
        unsigned x = cnt;
#pragma unroll
        for (int off = 1; off < 64; off <<= 1) { const unsigned y = (unsigned)__shfl_down((int)x, off); if (lane + off < 64) x += y; }
        const unsigned S = x - cnt, nd = need[row];
        const bool hit = (S < nd) && (S + cnt >= nd);
        unsigned run = S; int fb = -1; unsigned fn = 0u;
#pragma unroll
        for (int bi = BPL - 1; bi >= 0; --bi) {
            const unsigned c = (bi & 1) ? (wds[bi >> 1] >> 16) : (wds[bi >> 1] & 0xffffu);
            const bool here = (fb < 0) && (run + c >= nd);
            if (here) { fb = bi; fn = nd - run; }
            run += c;
        }
        if (hit) {
            const unsigned bin = (unsigned)(lane * BPL + fb);
            if (L == 1) { info[row] = bin; need[row] = fn; }
            if (L == 2) { info[row] = (info[row] << 11) | bin; need[row] = fn; }
            if (L == 3) { info[row] = (info[row] << 10) | bin; }
        }
    }
}

__device__ __forceinline__ void idx_zero_hist(LAS unsigned* hist, int tid) {
    LAS v4u* h4 = (LAS v4u*)hist;
#pragma unroll
    for (int i = 0; i < 16; ++i) h4[tid + 512 * i] = (v4u){0u, 0u, 0u, 0u};
}

__device__ __forceinline__ void idx_item(Frame& F, int b, int g) {
    LAS unsigned* hist = (LAS unsigned*)(F.lds + RING_OFF);
    LAS unsigned* info = (LAS unsigned*)(F.lds + INFO_OFF);
    LAS unsigned* need = info + 32;
    int tid_o = F.tid; asm volatile("" : "+v"(tid_o));
    const int tid = tid_o, lane = tid & 63, wave = F.wave, r = lane & 31, hh = lane >> 5;
    const bf16* Pb = (const bf16*)(F.ws + WS_B) + (size_t)b * T * N0;
    unsigned* maskrow = (unsigned*)(F.ws + WS_MASK) + ((size_t)(b * 256 + g)) * 8192;
    LAS f32x4* wtab = (LAS f32x4*)(info + 64);
    bf16x8 qa[4][4];
#pragma unroll
    for (int m = 0; m < 4; ++m) {
        const bf16* qp = Pb + (size_t)(32 * g + 8 * m + (r & 7)) * N0 + C0_IQ + (r >> 3) * 64 + 8 * hh;
#pragma unroll
        for (int ks = 0; ks < 4; ++ks) qa[m][ks] = *(const GAS bf16x8*)(qp + 16 * ks);
    }
    if (tid < 32) { const u32x2 wp = *(const GAS u32x2*)(Pb + (size_t)(32 * g + tid) * N0 + C0_IW); wtab[tid] = (f32x4){bflo(wp.x), bfhi(wp.x), bflo(wp.y), bfhi(wp.y)}; }
    const bf16* Kb = Pb + C0_IK;
    if (g >= 8) {
        idx_zero_hist(hist, tid); if (tid < 32) { info[tid] = 0u; need[tid] = 256u; }
        __syncthreads();
        idx_pass<1>(qa, wtab, Kb, g, hist, info, maskrow, wave, lane);
        __syncthreads();
        idx_scan<1>(hist, info, need, wave, lane);
        __syncthreads();
        idx_zero_hist(hist, tid);
        __syncthreads();
        idx_pass<2>(qa, wtab, Kb, g, hist, info, maskrow, wave, lane);
        __syncthreads();
        idx_scan<2>(hist, info, need, wave, lane);
        __syncthreads();
        idx_zero_hist(hist, tid);
        __syncthreads();
        idx_pass<3>(qa, wtab, Kb, g, hist, info, maskrow, wave, lane);
        __syncthreads();
        idx_scan<3>(hist, info, need, wave, lane);
        __syncthreads();
    } else {
        if (tid < 32) info[tid] = 0u;
        __syncthreads();
    }
    idx_pass<4>(qa, wtab, Kb, g, hist, info, maskrow, wave, lane);
    { const int s0 = 32 * (g + 1), s1 = 256 * ((g >> 3) + 1); for (int s = s0 + tid; s < s1; s += 512) maskrow[s] = 0u; }
    __syncthreads();
}

namespace att {
#define SBAR() __builtin_amdgcn_sched_barrier(0)
__device__ __forceinline__ int crow(int r, int hi) { return (r & 3) + 8 * (r >> 2) + 4 * hi; }
__device__ __forceinline__ unsigned cvtpk(float lo, float hi) { unsigned r; asm volatile("v_cvt_pk_bf16_f32 %0, %1, %2" : "=v"(r) : "v"(lo), "v"(hi)); return r; }
constexpr float THR_NAT = 8.0f;

__device__ __forceinline__ void partialSM(f32x16& p0, f32x16& p1, float& m_reg, float& mn, float& alpha, float C, float thr_raw) {
    float pmax = p0[0];
#pragma unroll
    for (int r = 1; r < 16; ++r) pmax = fmaxf(pmax, p0[r]);
#pragma unroll
    for (int r = 0; r < 16; ++r) pmax = fmaxf(pmax, p1[r]);
    { auto rr = __builtin_amdgcn_permlane32_swap(__float_as_uint(pmax), __float_as_uint(pmax), false, false);
      pmax = fmaxf(__uint_as_float(rr[0]), __uint_as_float(rr[1])); }
    if (__builtin_expect(__all(pmax - m_reg <= thr_raw), 1)) { mn = m_reg; alpha = 1.f; }
    else { mn = fmaxf(m_reg, pmax); alpha = __builtin_amdgcn_exp2f((m_reg - mn) * C); m_reg = mn; }
    const float mnC = -mn * C;
#pragma unroll
    for (int r = 0; r < 16; ++r) p0[r] = fmaf(p0[r], C, mnC);
#pragma unroll
    for (int r = 0; r < 16; ++r) p1[r] = fmaf(p1[r], C, mnC);
#pragma unroll
    for (int r = 0; r < 16; ++r) p0[r] = __builtin_amdgcn_exp2f(p0[r]);
}
__device__ __forceinline__ void finishSM(f32x16& p0, f32x16& p1, float alpha, float& l_reg, bf16x8& pa0, bf16x8& pa1, bf16x8& pa2, bf16x8& pa3) {
#pragma unroll
    for (int r = 0; r < 16; ++r) p1[r] = __builtin_amdgcn_exp2f(p1[r]);
    float ps = 0;
#pragma unroll
    for (int r = 0; r < 16; ++r) ps += p0[r];
#pragma unroll
    for (int r = 0; r < 16; ++r) ps += p1[r];
    { auto rr = __builtin_amdgcn_permlane32_swap(__float_as_uint(ps), __float_as_uint(ps), false, false);
      ps = __uint_as_float(rr[0]) + __uint_as_float(rr[1]); }
    l_reg = l_reg * alpha + ps;
#define PK4(P, BASE, OUT) do { unsigned a0 = cvtpk(P[BASE + 0], P[BASE + 1]), a1 = cvtpk(P[BASE + 2], P[BASE + 3]);   \
    unsigned b0 = cvtpk(P[BASE + 4], P[BASE + 5]), b1 = cvtpk(P[BASE + 6], P[BASE + 7]);                              \
    auto r0 = __builtin_amdgcn_permlane32_swap(a0, b0, false, false); auto r1 = __builtin_amdgcn_permlane32_swap(a1, b1, false, false); \
    v4u w = {r0[0], r1[0], r0[1], r1[1]}; OUT = __builtin_bit_cast(bf16x8, w); } while (0)
    PK4(p0, 0, pa0); PK4(p0, 8, pa1); PK4(p1, 0, pa2); PK4(p1, 8, pa3);
#undef PK4
}
template <int ND0>
__device__ __forceinline__ void qkt(f32x16& p0, f32x16& p1, const LAS char* Kb, const bf16x8 (&qr)[ND0], int r32, int hi) {
#pragma unroll
    for (int q = 0; q < 16; ++q) { p0[q] = 0.f; p1[q] = 0.f; }
#pragma unroll
    for (int d0 = 0; d0 < ND0; ++d0) {
        const bf16x8 b0 = *(const LAS bf16x8*)(Kb + (2 * d0 + hi) * 1024 + r32 * 16);
        const bf16x8 b1 = *(const LAS bf16x8*)(Kb + (2 * d0 + hi) * 1024 + (32 + r32) * 16);
        p0 = mfma32(b0, qr[d0], p0);
        p1 = mfma32(b1, qr[d0], p1); }
}
template <int NCB> __device__ __forceinline__ int v_st(int k, int c) { const int kk = (k & ~0xC) | ((k & 4) << 1) | ((k & 8) >> 1); return ((kk >> 3) * NCB + (c >> 5)) * 512 + ((kk & 7) * 32 + (c & 31)) * 2; }
__device__ __forceinline__ int v_rd_base(int lane) { return ((lane & 3) << 3) | (((lane >> 2) & 3) << 6) | (((lane >> 4) & 1) << 5) | (((lane >> 5) & 1) << 8); }
template <int OFF> __device__ __forceinline__ s16x4 tr_read(int vb) { s16x4 r; asm volatile("ds_read_b64_tr_b16 %0, %1 offset:%2" : "=&v"(r) : "v"(vb), "i"(OFF) : "memory"); return r; }
template <int NCB, int D0> __device__ __forceinline__ void pv_one(f32x16& od, int vb, bf16x8 pa0, bf16x8 pa1, bf16x8 pa2, bf16x8 pa3) {
    constexpr int KS = NCB * 1024, HF = NCB * 512, B0 = D0 * 512;
    const s16x4 l0 = tr_read<B0>(vb), h0 = tr_read<B0 + HF>(vb), l1 = tr_read<B0 + KS>(vb), h1 = tr_read<B0 + KS + HF>(vb);
    const s16x4 l2 = tr_read<B0 + 2 * KS>(vb), h2 = tr_read<B0 + 2 * KS + HF>(vb), l3 = tr_read<B0 + 3 * KS>(vb), h3 = tr_read<B0 + 3 * KS + HF>(vb);
    asm volatile("s_waitcnt lgkmcnt(0)" ::: "memory"); SBAR();
#define PK(L, H) (bf16x8){L[0], L[1], L[2], L[3], H[0], H[1], H[2], H[3]}
    od = mfma32(pa0, PK(l0, h0), od);
    od = mfma32(pa1, PK(l1, h1), od);
    od = mfma32(pa2, PK(l2, h2), od);
    od = mfma32(pa3, PK(l3, h3), od);
#undef PK
}
template <int NCB> __device__ __forceinline__ void pv_all(f32x16 (&o)[NCB], int vb, bf16x8 pa0, bf16x8 pa1, bf16x8 pa2, bf16x8 pa3) {
    pv_one<NCB, 0>(o[0], vb, pa0, pa1, pa2, pa3); pv_one<NCB, 1>(o[1], vb, pa0, pa1, pa2, pa3);
    if constexpr (NCB == 4) { pv_one<NCB, 2>(o[2], vb, pa0, pa1, pa2, pa3); pv_one<NCB, 3>(o[3], vb, pa0, pa1, pa2, pa3); }
}
__device__ __forceinline__ void cmask(f32x16& p0, f32x16& p1, int jb, int qrel, int hi) {
    const float NEG = -INFINITY; const int d = qrel - 64 * jb - 4 * hi;
#pragma unroll
    for (int r = 0; r < 16; ++r) { const int c = (r & 3) + 8 * (r >> 2); if (c > d) p0[r] = NEG; if (c + 32 > d) p1[r] = NEG; }
}
#ifdef DBG_SMASK_SHFL
__device__ __forceinline__ void smask(f32x16& p0, f32x16& p1, unsigned mw) {
    const float NEG = -INFINITY; const int lane = __lane_id(), r32 = lane & 31, hi = lane >> 5;
#pragma unroll
    for (int r = 0; r < 16; ++r) {
        const int k0 = (r & 3) + 8 * (r >> 2) + 4 * hi;
        const unsigned w0 = (unsigned)__shfl((int)mw, k0), w1 = (unsigned)__shfl((int)mw, 32 + k0);
        p0[r] = ((w0 >> r32) & 1u) ? p0[r] : NEG; p1[r] = ((w1 >> r32) & 1u) ? p1[r] : NEG;
    }
}
#else
__device__ __forceinline__ void smask(f32x16& p0, f32x16& p1, unsigned mw) {
    const float NEG = -INFINITY;
#pragma unroll
    for (int r = 0; r < 16; ++r) {
        const int k0 = (r & 3) + 8 * (r >> 2);
        { const unsigned lo = __builtin_amdgcn_readlane(mw, k0), hi_ = __builtin_amdgcn_readlane(mw, k0 + 4);
          const unsigned long long m64 = ((unsigned long long)hi_ << 32) | lo;
          p0[r] = __builtin_amdgcn_inverse_ballot_w64(m64) ? p0[r] : NEG; }
        { const unsigned lo = __builtin_amdgcn_readlane(mw, 32 + k0), hi_ = __builtin_amdgcn_readlane(mw, 36 + k0);
          const unsigned long long m64 = ((unsigned long long)hi_ << 32) | lo;
          p1[r] = __builtin_amdgcn_inverse_ballot_w64(m64) ? p1[r] : NEG; }
    }
}
#endif

struct AttnP {
    const bf16* Q; const bf16* K; const bf16* K2; const bf16* V; bf16* O; const bf16* G; const unsigned* mask; const float* cs; const float* sn;
    int ldq, ldk, ldk2, ldv, ldo, ldg; float C;
};
template <int DQK, int DV, bool MASKED, bool GATED, bool ROPEQ>
__device__ __forceinline__ void attn_unit(const AttnP& P, int qb, LAS char* lds, int tid_in) {
    int tid = tid_in; asm volatile("" : "+v"(tid));
    constexpr int ND0 = DQK / 16, NCB = DV / 32, KB_BYTES = DQK * 128, VB_BYTES = 64 * DV * 2, NK = (8 * DQK + 511) / 512, NV = (8 * DV) / 512;
    const int wid = __builtin_amdgcn_readfirstlane(tid >> 6), lane = tid & 63, r32 = lane & 31, hi = lane >> 5;
    LAS char* Vl = lds; LAS char* Kl = lds + 2 * VB_BYTES;
    LAS float* ws = (LAS float*)(lds + 2 * VB_BYTES + 2 * KB_BYTES) + wid * 64; LAS float* li_l = ws; LAS float* al_l = ws + 32;
    LAS bf16* stg = (LAS bf16*)(lds + 2 * VB_BYTES + 2 * KB_BYTES + 2048) + wid * (32 * DV);
    const int q0 = qb * 256;
    const float C = P.C, thr_raw = THR_NAT * 1.4426950408889634f / C;
    float m_reg = -1e30f, l_reg = 0.f; f32x16 o[NCB]; bf16x8 qr[ND0];
#pragma unroll
    for (int d = 0; d < NCB; ++d)
#pragma unroll
        for (int q = 0; q < 16; ++q) o[d][q] = 0.f;
    {
        const bf16* Qw = P.Q + (size_t)(q0 + wid * 32 + r32) * P.ldq + hi * 8;
#pragma unroll
        for (int d0 = 0; d0 < ND0; ++d0) qr[d0] = *(const GAS bf16x8*)(Qw + d0 * 16);
        if constexpr (ROPEQ) {
            const float* cp = P.cs + (size_t)(q0 + wid * 32 + r32) * 16 + 8 * hi; const float* sp = P.sn + (size_t)(q0 + wid * 32 + r32) * 16 + 8 * hi;
            const f32x4 c0 = *(const GAS f32x4*)cp, c1 = *(const GAS f32x4*)(cp + 4), s0 = *(const GAS f32x4*)sp, s1 = *(const GAS f32x4*)(sp + 4);
            const float co[8] = {c0.x, c0.y, c0.z, c0.w, c1.x, c1.y, c1.z, c1.w}, si[8] = {s0.x, s0.y, s0.z, s0.w, s1.x, s1.y, s1.z, s1.w};
            bf16x8 a = qr[ND0 - 2], bq = qr[ND0 - 1];
#pragma unroll
            for (int j = 0; j < 8; ++j) { const float x1 = bf2f((bf16)a[j]), x2 = bf2f((bf16)bq[j]);
                a[j] = (short)f2bf(x1 * co[j] - x2 * si[j]); bq[j] = (short)f2bf(x1 * si[j] + x2 * co[j]); }
            qr[ND0 - 2] = a; qr[ND0 - 1] = bq;
        }
    }
    unsigned kofg[NK]; int koff[NK]; bool kval[NK];
    { const int row = 8 * (tid >> 6) + (tid & 7), c = (tid & 63) >> 3; kofg[0] = (unsigned)(row * P.ldk + c * 8); koff[0] = c * 1024 + row * 16; kval[0] = true; }
    if constexpr (NK == 2) { const int row = 8 * ((tid & 255) >> 5) + (tid & 7), c = (tid & 31) >> 3; kofg[1] = (unsigned)(row * P.ldk2 + c * 8); koff[1] = (8 + c) * 1024 + row * 16; kval[1] = tid < 256; }
    unsigned vofg[NV]; int voff[NV];
#pragma unroll
    for (int i = 0; i < NV; ++i) { const int p = tid + 512 * i, row = p / (DV / 8), c8 = (p % (DV / 8)) * 8; voff[i] = v_st<NCB>(row, c8); vofg[i] = (unsigned)(row * P.ldv + c8); }
    const int vb0 = (int)(unsigned)(uintptr_t)Vl + v_rd_base(lane);
    const unsigned* mrow = MASKED ? P.mask + (size_t)(8 * qb + wid) * 8192 + lane : nullptr;
    bf16x8 ksr[NK], vsr[NV]; unsigned mw = 0u, mwn = 0u;
#define SLOAD(k0) do { { const bf16* kb_u = P.K + (size_t)(k0) * P.ldk; ksr[0] = *(const GAS bf16x8*)(kb_u + kofg[0]); } \
    if constexpr (NK == 2) { const bf16* kb2_u = P.K2 + (size_t)(k0) * P.ldk2; if (kval[1]) ksr[1] = *(const GAS bf16x8*)(kb2_u + kofg[1]); } \
    { const bf16* vb_u = P.V + (size_t)(k0) * P.ldv; _Pragma("unroll") for (int i_ = 0; i_ < NV; ++i_) vsr[i_] = *(const GAS bf16x8*)(vb_u + vofg[i_]); } \
    if (MASKED) { DBG_MWLOAD(k0); } } while (0)
#define SWRITE(b) do { _Pragma("unroll") for (int i_ = 0; i_ < NK; ++i_) if (kval[i_]) *(LAS bf16x8*)(Kl + (b) * KB_BYTES + koff[i_]) = ksr[i_]; \
    _Pragma("unroll") for (int i_ = 0; i_ < NV; ++i_) *(LAS bf16x8*)(Vl + (b) * VB_BYTES + voff[i_]) = vsr[i_]; mw = mwn; } while (0)
#define SWAIT() asm volatile("s_waitcnt vmcnt(0)" ::: "memory")
#define RESC(a) do { if (__any((a) < 1.f)) { if (hi == 0) al_l[r32] = (a); asm volatile("s_waitcnt lgkmcnt(0)" ::: "memory"); \
    _Pragma("unroll") for (int d_ = 0; d_ < NCB; ++d_) _Pragma("unroll") for (int r_ = 0; r_ < 16; ++r_) o[d_][r_] *= al_l[crow(r_, hi)]; } } while (0)
    const int NT = (q0 + 256) / 64, qrel = wid * 32 + r32;
#ifdef DBG_MW_ONES
#define DBG_MWLOAD(k0) mwn = 0xFFFFFFFFu
#define MASKT(P0, P1, t) do { if (MASKED) smask(P0, P1, mw); { const int jb_ = (t) - (NT - 4); if (jb_ >= 0) cmask(P0, P1, jb_, qrel, hi); } } while (0)
#else
#define DBG_MWLOAD(k0) mwn = mrow[(k0)]
#ifdef DBG_BOTH_MASKS
#define MASKT(P0, P1, t) do { if (MASKED) smask(P0, P1, mw | DBG_OR); { const int jb_ = (t) - (NT - 4); if (jb_ >= 0) cmask(P0, P1, jb_, qrel, hi); } } while (0)
#else
#define MASKT(P0, P1, t) do { if (MASKED) smask(P0, P1, mw); else { const int jb_ = (t) - (NT - 4); if (jb_ >= 0) cmask(P0, P1, jb_, qrel, hi); } } while (0)
#endif
#endif
    f32x16 pA0, pA1, pB0, pB1; float mnA, mnB, alA, alB; bf16x8 pa0, pa1, pa2, pa3;
    SLOAD(0); SWAIT(); SWRITE(0); __syncthreads();
    qkt<ND0>(pA0, pA1, Kl, qr, r32, hi); MASKT(pA0, pA1, 0); partialSM(pA0, pA1, m_reg, mnA, alA, C, thr_raw);
    SLOAD(64); SWAIT(); SWRITE(1); __syncthreads();
    for (int j = 1; j + 1 < NT; j += 2) {
        SBAR(); qkt<ND0>(pB0, pB1, Kl + KB_BYTES, qr, r32, hi); MASKT(pB0, pB1, j);
        finishSM(pA0, pA1, alA, l_reg, pa0, pa1, pa2, pa3); SBAR();
        SLOAD((j + 1) * 64); SBAR();
        pv_all<NCB>(o, vb0, pa0, pa1, pa2, pa3); partialSM(pB0, pB1, m_reg, mnB, alB, C, thr_raw);
        __syncthreads(); SWAIT(); SWRITE(0);
        RESC(alB); __syncthreads();
        SBAR(); qkt<ND0>(pA0, pA1, Kl, qr, r32, hi); MASKT(pA0, pA1, j + 1);
        finishSM(pB0, pB1, alB, l_reg, pa0, pa1, pa2, pa3); SBAR();
        SLOAD((j + 2) * 64); SBAR();
        pv_all<NCB>(o, vb0 + VB_BYTES, pa0, pa1, pa2, pa3); partialSM(pA0, pA1, m_reg, mnA, alA, C, thr_raw);
        __syncthreads(); SWAIT(); SWRITE(1);
        RESC(alA); __syncthreads();
    }
    SBAR(); qkt<ND0>(pB0, pB1, Kl + KB_BYTES, qr, r32, hi); MASKT(pB0, pB1, NT - 1);
    finishSM(pA0, pA1, alA, l_reg, pa0, pa1, pa2, pa3); SBAR();
    pv_all<NCB>(o, vb0, pa0, pa1, pa2, pa3); partialSM(pB0, pB1, m_reg, mnB, alB, C, thr_raw);
    RESC(alB);
    finishSM(pB0, pB1, alB, l_reg, pa0, pa1, pa2, pa3); SBAR();
    pv_all<NCB>(o, vb0 + VB_BYTES, pa0, pa1, pa2, pa3);
    int lane_e = lane; asm volatile("" : "+v"(lane_e));
    const int r32e = lane_e & 31, hie = lane_e >> 5;
    if (hie == 0) li_l[r32e] = l_reg;
    asm volatile("s_waitcnt lgkmcnt(0)" ::: "memory");
    const size_t orow0 = (size_t)(q0 + wid * 32);
    LAS bf16* stg_e = stg + r32e;
    const bf16* gp = GATED ? P.G + orow0 * P.ldg : nullptr;
#pragma unroll
    for (int r = 0; r < 16; ++r) { const int orow = crow(r, hie); const float rl = __builtin_amdgcn_rcpf(li_l[orow]);
#pragma unroll
        for (int d0 = 0; d0 < NCB; ++d0) { float v = o[d0][r] * rl;
            if constexpr (GATED) { const float gte = bf2f(gp[(unsigned)(orow * P.ldg + d0 * 32 + r32e)]); v *= silu(gte); }
            stg_e[orow * DV + d0 * 32] = (bf16)f2bf(v); } }
    asm volatile("s_waitcnt lgkmcnt(0)" ::: "memory");
    constexpr int CPR = DV / 8, RPI = 64 / CPR;
    bf16* op = P.O + orow0 * P.ldo;
#pragma unroll
    for (int i = 0; i < 32 / RPI; ++i) { const int row = i * RPI + lane_e / CPR, ch = lane_e % CPR;
        const v4u v = *(const LAS v4u*)(stg + row * DV + ch * 8); *(GAS v4u*)(op + (unsigned)(row * P.ldo + ch * 8)) = v; }
    __syncthreads();
#undef SLOAD
#undef SWRITE
#undef SWAIT
#undef RESC
#undef MASKT
}
#undef SBAR
}

__device__ __forceinline__ void mla_prep_rows(Frame& F) {
    const int gw = F.vcu * NWAVES + F.wave, NGW = F.G * NWAVES, lane = F.lane;
    const bf16* P = (const bf16*)(F.ws + WS_B);
    bf16* cqn = (bf16*)(F.ws + WS_MASK); bf16* ckvn = (bf16*)(F.ws + WS_MASK + 8 * MiB); bf16* krope = (bf16*)(F.ws + WS_KROPE);
    const float* cosD = (const float*)(F.ws + WS_ROPE) + (size_t)M * 64; const float* sinD = cosD + (size_t)M * 16;
    for (int t = gw; t < M; t += NGW) {
        const bf16* pr = P + (size_t)t * N1;
        { const u32x2 w = *(const GAS u32x2*)(pr + C1_DCQ + 4 * lane); const float a = bflo(w.x), b = bfhi(w.x), c = bflo(w.y), d = bfhi(w.y);
          const float r = 1.0f / sqrtf(wave_sum(a * a + b * b + c * c + d * d) * (1.f / 256.f) + NORM_EPS);
          const f32x4 g = *(const GAS f32x4*)(F.q_norm + 4 * lane);
          *(GAS u32x2*)(cqn + (size_t)t * 256 + 4 * lane) = (u32x2){pk2(a * r * g.x, b * r * g.y), pk2(c * r * g.z, d * r * g.w)}; }
        { const unsigned w = *(const GAS unsigned*)(pr + C1_DCKV + 2 * lane); const float a = bflo(w), b = bfhi(w);
          const float r = 1.0f / sqrtf(wave_sum(a * a + b * b) * (1.f / 128.f) + NORM_EPS);
          *(GAS unsigned*)(ckvn + (size_t)t * 128 + 2 * lane) = pk2(a * r * F.kv_norm[2 * lane], b * r * F.kv_norm[2 * lane + 1]); }
        if (lane < 16) { const float x1 = bf2f(pr[C1_DKR + lane]), x2 = bf2f(pr[C1_DKR + 16 + lane]); const float c = cosD[(size_t)t * 16 + lane], s = sinD[(size_t)t * 16 + lane];
          krope[(size_t)t * 32 + lane] = (bf16)f2bf(x1 * c - x2 * s); krope[(size_t)t * 32 + 16 + lane] = (bf16)f2bf(x1 * s + x2 * c); }
    }
}
__device__ __forceinline__ void diff_finalize_rows(Frame& F) {
    const int gw = F.vcu * NWAVES + F.wave, NGW = F.G * NWAVES, lane = F.lane;
    const bf16* P = (const bf16*)(F.ws + WS_B); const bf16* oC = (const bf16*)(F.ws + WS_MASK); bf16* MIX = (bf16*)(F.ws + WS_A);
    const float lam_init = 0.8f - 0.6f * 0.74081822068171786607f;
    const float d1 = wave_sum(F.diff_lambda[lane] * F.diff_lambda[64 + lane]), d2 = wave_sum(F.diff_lambda[128 + lane] * F.diff_lambda[192 + lane]);
    const float lam = __expf(d1) - __expf(d2) + lam_init;
    const int h = lane >> 4, e0 = (lane & 15) * 8;
    float sub[8];
#pragma unroll
    for (int j = 0; j < 8; ++j) sub[j] = F.diff_subln[e0 + j] * (1.0f - lam_init);
    for (int t = gw; t < M; t += NGW) {
        const v4u a = *(const GAS v4u*)(oC + (size_t)t * 1024 + h * 128 + e0), b = *(const GAS v4u*)(oC + (size_t)t * 1024 + (4 + h) * 128 + e0);
        const v4u gv = *(const GAS v4u*)(P + (size_t)t * N1 + C1_CG + h * 128 + e0);
        const unsigned aw[4] = {a.x, a.y, a.z, a.w}, bw[4] = {b.x, b.y, b.z, b.w}, gw4[4] = {gv.x, gv.y, gv.z, gv.w};
        float d[8]; float s = 0.f;
#pragma unroll
        for (int j = 0; j < 8; ++j) { const float x = (j & 1) ? bfhi(aw[j >> 1]) : bflo(aw[j >> 1]), y = (j & 1) ? bfhi(bw[j >> 1]) : bflo(bw[j >> 1]); d[j] = x - lam * y; s += d[j] * d[j]; }
        s += __shfl_xor(s, 1); s += __shfl_xor(s, 2); s += __shfl_xor(s, 4); s += __shfl_xor(s, 8);
        const float r = 1.0f / sqrtf(s * (1.f / 128.f) + NORM_EPS);
        float o[8];
#pragma unroll
        for (int j = 0; j < 8; ++j) { const float g = (j & 1) ? bfhi(gw4[j >> 1]) : bflo(gw4[j >> 1]); o[j] = d[j] * r * sub[j] * silu(g); }
        *(GAS v4u*)(MIX + (size_t)t * DM + h * 128 + e0) = (v4u){pk2(o[0], o[1]), pk2(o[2], o[3]), pk2(o[4], o[5]), pk2(o[6], o[7])};
    }
}

constexpr int N_PHASES = 14;
struct Args { const void* in[14]; float* out; unsigned char* ws; int ph_lo, ph_hi; };
__global__ void __launch_bounds__(NWAVES * 64, 2) fwd_kernel(Args args) {
    extern __shared__ __attribute__((aligned(16))) unsigned char lds[];
    Frame F;
    F.lds = (LAS unsigned char*)lds;
    F.MISC = (volatile LAS unsigned*)(F.lds + MISC_OFF);
    F.tid = threadIdx.x; F.lane = F.tid & 63; F.wave = __builtin_amdgcn_readfirstlane(F.tid >> 6);
    F.G = gridDim.x; { const int bx = blockIdx.x; F.vcu = (F.G % 8 == 0) ? (bx % 8) * (F.G / 8) + bx / 8 : bx; }
    F.ws = args.ws; F.ctl = (gu32*)(args.ws + WS_CTL);
    F.x = (const float*)args.in[0]; F.pos = (const int*)args.in[1]; F.pre_norm = (const float*)args.in[2]; F.post_norm = (const float*)args.in[3];
    F.w_in_even = (const float*)args.in[4]; F.w_out_even = (const float*)args.in[5]; F.w_in_odd = (const float*)args.in[6]; F.diff_lambda = (const float*)args.in[7];
    F.diff_subln = (const float*)args.in[8]; F.q_norm = (const float*)args.in[9]; F.kv_norm = (const float*)args.in[10]; F.w_uq = (const float*)args.in[11];
    F.w_ukv = (const float*)args.in[12]; F.w_out_odd = (const float*)args.in[13]; F.out = args.out;
    for (int u = F.tid; u < (LDS_BYTES - LDSCTL_OFF) / 4; u += NWAVES * 64) ((LAS unsigned*)(F.lds + LDSCTL_OFF))[u] = 0u;
    __syncthreads();
    XcdBarrier bar; bar.bar = (unsigned*)(F.ctl + CW_BAR); bar.x = 0; bar.st = nullptr;
    if (MK_N_LAUNCHES == 1) bar = xcd_barrier_post((unsigned*)(F.ctl + CW_BAR), F.MISC + 8);
    const int lo = args.ph_lo, hi = args.ph_hi;
#ifdef ONLY_PHASE
#define IN(k) ((k) == ONLY_PHASE && lo <= (k) && (k) < hi)
#else
#define IN(k) (lo <= (k) && (k) < hi)
#endif
#define SEAM(k) do { if (MK_N_LAUNCHES == 1 && IN(k) && IN((k) + 1)) xcd_barrier(bar); } while (0)
    bf16* const HA = (bf16*)(F.ws + WS_A);
    bf16* const PB = (bf16*)(F.ws + WS_B);
    float* const MB = (float*)(F.ws + WS_B);
    LAS char* const alds = (LAS char*)(F.lds + RING_OFF);

    if (IN(0)) { p0_prologue(F); }
    SEAM(0);
#if MK_STAGE == 1
    if (IN(1)) { const int gt = F.vcu * (NWAVES * 64) + F.tid, NGT = F.G * NWAVES * 64; for (size_t e = gt; e < (size_t)M * DM / 4; e += NGT) ((f32x4*)F.out)[e] = ((const f32x4*)F.x)[e]; }
#else
    if (IN(1)) { pg8::Gemm g{HA, (const bf16*)(F.ws + WS_W0T), M, N0, DM}; pg8::StaticOrder S; S.init(M, N0, F.G, (int)blockIdx.x);
        pg8::EpiBf16<0> E{PB, N0, nullptr, 0, 0, 1.f};
        pg8::gemm_phase<pg8::EpiBf16<0>, pg8::StaticOrder, true, true>(F.lds + RING_OFF, g, S, E); }
    SEAM(1);
    if (IN(2)) {
        for (int it = F.vcu; it < 512; it += F.G) ret_u_item(F, it);
        for (int c = F.vcu; c < 256; c += F.G) { const int b = c >> 7, gi = c & 127;
#pragma unroll 1
            for (int k = 0; k < 2; ++k) idx_item(F, b, k ? gi : 255 - gi); }
    }
#ifdef DBG_SIMPLE_MASK
    if (IN(2)) {
        xcd_barrier(bar);
        unsigned* mk = (unsigned*)(F.ws + WS_MASK);
        const size_t gt = (size_t)F.vcu * (NWAVES * 64) + F.tid, NGT = (size_t)F.G * NWAVES * 64;
        for (size_t e = gt; e < (size_t)2 * 256 * 8192; e += NGT) { const int s_ = (int)(e & 8191), g_ = (int)((e >> 13) & 255);
            const int d = s_ - 32 * g_; mk[e] = d < 0 ? 0xFFFFFFFFu : d > 31 ? 0u : (0xFFFFFFFFu << d); }
    }
#endif
    SEAM(2);
    if (IN(3)) { ret_scan(F); }
    SEAM(3);
    if (IN(4)) {
#if defined(DBG_NO_A) || defined(DBG_NO_RET)
        { const int gt = F.vcu * (NWAVES * 64) + F.tid, NGT = F.G * NWAVES * 64;
          for (size_t e = gt; e < (size_t)M * 64; e += NGT) { const size_t row = e >> 6, c8 = (e & 63) * 8;
#ifdef DBG_NO_A
              *(v4u*)(HA + row * DM + c8) = (v4u){0u, 0u, 0u, 0u};
#endif
#ifdef DBG_NO_RET
              *(v4u*)(HA + row * DM + 512 + c8) = (v4u){0u, 0u, 0u, 0u};
#endif
          } }
#endif
#ifndef DBG_NO_A
        for (int pu = F.vcu; pu < 256; pu += F.G) {
            const int bh = pu >> 4, s = pu & 15, b = bh >> 3, h = bh & 7;
            att::AttnP A;
            const bf16* Pb = PB + (size_t)b * T * N0;
            A.Q = Pb + C0_AQ + h * 64; A.K = Pb + C0_AK + h * 64; A.K2 = nullptr; A.V = Pb + C0_AV + h * 64; A.G = Pb + C0_AG + h * 64;
            A.O = HA + (size_t)b * T * DM + h * 64; A.mask = (const unsigned*)(F.ws + WS_MASK) + (size_t)b * 256 * 8192; A.cs = nullptr; A.sn = nullptr;
            A.ldq = N0; A.ldk = N0; A.ldk2 = 0; A.ldv = N0; A.ldo = DM; A.ldg = N0; A.C = 0.125f * 1.4426950408889634f;
#pragma unroll 1
#ifdef DBG_A_CAUSAL
            for (int k = 0; k < 2; ++k) att::attn_unit<64, 64, false, true, false>(A, k ? s : 31 - s, alds, F.tid);
#else
            for (int k = 0; k < 2; ++k) att::attn_unit<64, 64, true, true, false>(A, k ? s : 31 - s, alds, F.tid);
#endif
        }
#endif
#ifndef DBG_NO_RET
        for (int it = F.vcu; it < 512; it += F.G) ret_out_item(F, it);
#endif
    }
    SEAM(4);
    if (IN(5)) { pg8::Gemm g{HA, (const bf16*)(F.ws + WS_WO0T), M, DM, DM}; pg8::StaticOrder S; S.init(M, DM, F.G, (int)blockIdx.x);
        EpiF32 E{MB, DM};
        pg8::gemm_phase<EpiF32, pg8::StaticOrder, false, true>(F.lds + RING_OFF, g, S, E); }
    SEAM(5);
    if (IN(6)) { post_norm_rows<true>(F, F.x, MB, F.post_norm, F.pre_norm + DM, F.out, HA); }
    SEAM(6);
#if MK_STAGE >= 3
    if (IN(7)) { pg8::Gemm g{HA, (const bf16*)(F.ws + WS_W1T), M, N1, DM}; pg8::StaticOrder S; S.init(M, N1, F.G, (int)blockIdx.x);
        pg8::EpiBf16<0> E{PB, N1, nullptr, 0, 0, 1.f};
        pg8::gemm_phase<pg8::EpiBf16<0>, pg8::StaticOrder, true, true>(F.lds + RING_OFF, g, S, E); }
    SEAM(7);
    if (IN(8)) { mla_prep_rows(F); }
    SEAM(8);
    if (IN(9)) {
        { pg8::Gemm g{(const bf16*)(F.ws + WS_MASK), (const bf16*)(F.ws + WS_WUQT), M, 768, 256}; pg8::StaticOrder S; S.init(M, 768, F.G, (int)blockIdx.x);
          pg8::EpiBf16<0> E{(bf16*)(F.ws + WS_QD), 768, nullptr, 0, 0, 1.f};
          pg8::gemm_phase<pg8::EpiBf16<0>, pg8::StaticOrder, true, true>(F.lds + RING_OFF, g, S, E); }
        __syncthreads();
        { pg8::Gemm g{(const bf16*)(F.ws + WS_MASK + 8 * MiB), (const bf16*)(F.ws + WS_WUKVT), M, 1024, 128}; pg8::StaticOrder S; S.init(M, 1024, F.G, (int)blockIdx.x);
          pg8::EpiBf16<0> E{(bf16*)(F.ws + WS_KVX), 1024, nullptr, 0, 0, 1.f};
          pg8::gemm_phase<pg8::EpiBf16<0>, pg8::StaticOrder, true, true>(F.lds + RING_OFF, g, S, E); }
    }
    SEAM(9);
    if (IN(10)) {
        for (int pu = F.vcu; pu < 256; pu += F.G) {
            const int bh = pu >> 4, s = pu & 15, b = bh >> 3, hs = bh & 7;
#ifndef PH10_NO_C
            {   att::AttnP A; const bf16* Pb = PB + (size_t)b * T * N1; const int h = hs & 3, mp = hs >> 2;
                A.Q = Pb + C1_CQ + h * 128 + 64 * mp; A.K = Pb + C1_CK + h * 128 + 64 * mp; A.K2 = nullptr; A.V = Pb + C1_CV + h * 128; A.G = nullptr;
                A.O = (bf16*)(F.ws + WS_MASK) + (size_t)b * T * 1024 + hs * 128; A.mask = nullptr; A.cs = nullptr; A.sn = nullptr;
                A.ldq = N1; A.ldk = N1; A.ldk2 = 0; A.ldv = N1; A.ldo = 1024; A.ldg = 0; A.C = 0.125f * 1.4426950408889634f;
#pragma unroll 1
                for (int k = 0; k < 2; ++k) att::attn_unit<64, 128, false, false, false>(A, k ? s : 31 - s, alds, F.tid); }
#endif
#ifndef PH10_NO_D
            {   att::AttnP A; const int h = hs;
                A.Q = (const bf16*)(F.ws + WS_QD) + (size_t)b * T * 768 + h * 96; A.K = (const bf16*)(F.ws + WS_KVX) + (size_t)b * T * 1024 + h * 128;
                A.K2 = (const bf16*)(F.ws + WS_KROPE) + (size_t)b * T * 32; A.V = (const bf16*)(F.ws + WS_KVX) + (size_t)b * T * 1024 + h * 128 + 64;
                A.G = PB + (size_t)b * T * N1 + C1_DG + h * 64; A.O = HA + (size_t)b * T * DM + 512 + h * 64; A.mask = nullptr;
                A.cs = (const float*)(F.ws + WS_ROPE) + (size_t)M * 64 + (size_t)b * T * 16; A.sn = A.cs + (size_t)M * 16;
                A.ldq = 768; A.ldk = 1024; A.ldk2 = 32; A.ldv = 1024; A.ldo = DM; A.ldg = N1; A.C = 0.10206207261596575f * 1.4426950408889634f;
#pragma unroll 1
                for (int k = 0; k < 2; ++k) att::attn_unit<96, 64, false, true, true>(A, k ? s : 31 - s, alds, F.tid); }
#endif
        }
    }
    SEAM(10);
    if (IN(11)) { diff_finalize_rows(F); }
    SEAM(11);
    if (IN(12)) { pg8::Gemm g{HA, (const bf16*)(F.ws + WS_WO1T), M, DM, DM}; pg8::StaticOrder S; S.init(M, DM, F.G, (int)blockIdx.x);
        EpiF32 E{MB, DM};
        pg8::gemm_phase<EpiF32, pg8::StaticOrder, false, true>(F.lds + RING_OFF, g, S, E); }
    SEAM(12);
    if (IN(13)) { post_norm_rows<false>(F, F.out, MB, F.post_norm + DM, nullptr, F.out, nullptr); }
#endif
#endif
#undef IN
#undef SEAM
}

extern "C" void kernel_launch(void* const* d_in, const int* in_sizes, int n_in, void* d_out, int out_size, void* d_ws, size_t ws_size, hipStream_t stream) {
    static int grid = 0;
    if (grid == 0) {
        if (n_in != 14 || in_sizes[0] != M * DM || out_size != M * DM || ws_size < WS_END) { fprintf(stderr, "kernel_launch: unexpected shapes (n_in %d, in0 %d, out %d, ws %zu); nothing launched\n", n_in, n_in > 0 ? in_sizes[0] : -1, out_size, ws_size); grid = -1; return; }
        int dev = 0, cus = 0, per_cu = 0;
        if (hipGetDevice(&dev) != hipSuccess || hipDeviceGetAttribute(&cus, hipDeviceAttributeMultiprocessorCount, dev) != hipSuccess) { grid = -1; return; }
        if (hipFuncSetAttribute((const void*)fwd_kernel, hipFuncAttributeMaxDynamicSharedMemorySize, LDS_BYTES) != hipSuccess) { fprintf(stderr, "kernel_launch: hipFuncSetAttribute failed\n"); grid = -1; return; }
        if (hipOccupancyMaxActiveBlocksPerMultiprocessor(&per_cu, (const void*)fwd_kernel, NWAVES * 64, LDS_BYTES) != hipSuccess || per_cu < 1)
            fprintf(stderr, "kernel_launch: note: occupancy query reports %d workgroups per CU\n", per_cu);
        (void)hipGetLastError();
        grid = cus;
    }
    if (grid < 0) return;
    if (hipMemsetAsync((char*)d_ws + WS_CTL, 0, CTL_ZERO_BYTES, stream) != hipSuccess) { fprintf(stderr, "kernel_launch: hipMemsetAsync failed\n"); return; }
    Args a{};
    for (int i = 0; i < 14; ++i) a.in[i] = d_in[i];
    a.out = (float*)d_out; a.ws = (unsigned char*)d_ws;
#if MK_N_LAUNCHES == 1
    a.ph_lo = 0; a.ph_hi = N_PHASES;
    hipLaunchKernelGGL(fwd_kernel, dim3(grid), dim3(NWAVES * 64), LDS_BYTES, stream, a);
#else
    for (int p = 0; p < N_PHASES; ++p) { a.ph_lo = p; a.ph_hi = p + 1; hipLaunchKernelGGL(fwd_kernel, dim3(grid), dim3(NWAVES * 64), LDS_BYTES, stream, a); }
#endif
    const hipError_t le = hipPeekAtLastError();
    if (le != hipSuccess) fprintf(stderr, "kernel_launch: launch failed: %s\n", hipGetErrorName(le));
}
```

```cpp
#include <hip/hip_runtime.h>
#include <cstdio>
#include <cstdint>
#ifndef MK_STAGE
#define MK_STAGE 3
#endif
#ifndef PROBE_DUP
#define PROBE_DUP 0x0
#endif
#ifndef MK_N_LAUNCHES
#define MK_N_LAUNCHES 1
#endif
namespace pg8 {
#define PG8_LAS __attribute__((address_space(3)))
typedef unsigned short bf16_t;
typedef short bf16x8 __attribute__((ext_vector_type(8)));
typedef float f32x4 __attribute__((ext_vector_type(4)));
typedef unsigned u32x4 __attribute__((ext_vector_type(4)));
constexpr int BM = 256, BK = 64, HALF = 128, HTB = HALF * BK * 2  , STAGE_BYTES = 8 * HTB, NXCD = 8, WGM = 8;

__host__ __device__ __forceinline__ int lds_byte(int r, int c) { const int st = (r >> 4) * 2 + (c >> 5), rr = r & 15, cc = c & 31, ob = rr * 64 + cc * 2; return st * 1024 + (ob ^ (((ob >> 9) & 1) << 5)); }
__host__ __device__ __forceinline__ void stage_rc(int b, int& R, int& C) { const int st = b / 1024, sb = b % 1024, swz = sb ^ (((sb >> 9) & 1) << 5); R = (st >> 1) * 16 + swz / 64; C = (st & 1) * 32 + (swz % 64) / 2; }
__host__ __device__ __forceinline__ int perm32(int rho) { const int n = rho >> 4, i = rho & 15; return 8 * (i >> 2) + 4 * n + (i & 3); }

struct Unit { int pm, pn; };
struct Gemm { const bf16_t* A; const bf16_t* Bt; int M, N, K; };

struct StaticOrder {
    int nM, nN, nwg, G, c;
    __host__ __device__ void init(int M, int N, int G_, int c_) { nM = M / BM; nN = N / BM; nwg = nM * nN; G = G_; c = c_; }
    __host__ __device__ bool next(int i, Unit& u) const {
        const long L = (long)i * G + c; if (L >= nwg) return false;
        int wgid = (int)L; { const int q = nwg / NXCD, r = nwg % NXCD, xcd = wgid % NXCD, off = wgid / NXCD; wgid = (xcd < r ? xcd * (q + 1) : r * (q + 1) + (xcd - r) * q) + off; }
        const int nig = WGM * nN, gid = wgid / nig, fm = gid * WGM, gsz = (nM - fm) < WGM ? (nM - fm) : WGM;
        u.pm = fm + ((wgid % nig) % gsz); u.pn = (wgid % nig) / gsz; return true;
    }
    __device__ __forceinline__ void a_ready(const Unit&) const {}
    __device__ __forceinline__ void done(const Unit&) const {}
};

__device__ __forceinline__ unsigned cvt_pk_bf16(float lo, float hi) { unsigned r; asm volatile("v_cvt_pk_bf16_f32 %0, %1, %2" : "=v"(r) : "v"(lo), "v"(hi)); return r; }
typedef float f32x2 __attribute__((ext_vector_type(2)));
__device__ __forceinline__ f32x2 gelu_pk(f32x2 v) {
    const f32x2 av = __builtin_elementwise_abs(v), d = av * 0.2316418882f + 1.0f;
    f32x2 t; t.x = __builtin_amdgcn_rcpf(d.x); t.y = __builtin_amdgcn_rcpf(d.y);
    f32x2 q = t * 0.5307027145f + (-0.7265760135f); q = q * t + 0.7107068705f; q = q * t + (-0.142248368f); q = q * t + 0.127414796f; q = q * t;
    const f32x2 s = (v * v) * (-0.72134752044f);
    f32x2 e; e.x = __builtin_amdgcn_exp2f(s.x); e.y = __builtin_amdgcn_exp2f(s.y);
    const f32x2 m = v * (q * e), r = v - m;
    f32x2 o; o.x = v.x < 0.f ? m.x : r.x; o.y = v.y < 0.f ? m.y : r.y; return o;
}

template <int ACT  > struct EpiBf16 {
    static constexpr bool PERM = true, AFTER_DRAIN = false; static_assert(ACT == 0 || ACT == 1, "EpiBf16: ACT is 0 (none) or 1 (gelu_pk)");
    bf16_t* O; int ldc; const float* bias; int split_cols; size_t split_stride; float scale0;
    __device__ __forceinline__ void operator()(const f32x4 (&acc)[2][2][4][2], const Unit& u, int wr, int wc, int fr, int fq) const {
        const int row0 = u.pm * BM + wr * 64 + fr; int colt = u.pn * BM; bf16_t* base = O;
        float sc = 1.f; if (split_cols) { const int t = colt / split_cols; base += (size_t)t * split_stride; colt -= t * split_cols; if (t == 0) sc = scale0; }
        const int col0 = colt + wc * 32 + 8 * fq, bcol0 = u.pn * BM + wc * 32 + 8 * fq;
        f32x4 bv[2][2];
#pragma unroll
        for (int bj = 0; bj < 2; ++bj)
#pragma unroll
            for (int n = 0; n < 2; ++n) bv[bj][n] = bias ? *(const f32x4*)(bias + bcol0 + bj * HALF + 4 * n) : (f32x4){0.f, 0.f, 0.f, 0.f};
#pragma unroll
        for (int ai = 0; ai < 2; ++ai)
#pragma unroll
            for (int m = 0; m < 4; ++m) { bf16_t* rowp = base + (size_t)(row0 + ai * HALF + m * 16) * ldc + col0;
#pragma unroll
                for (int bj = 0; bj < 2; ++bj) { f32x4 v0 = acc[ai][bj][m][0] + bv[bj][0], v1 = acc[ai][bj][m][1] + bv[bj][1];
                    if (ACT == 1) { f32x2 a = gelu_pk((f32x2){v0[0], v0[1]}), b = gelu_pk((f32x2){v0[2], v0[3]}), c = gelu_pk((f32x2){v1[0], v1[1]}), d = gelu_pk((f32x2){v1[2], v1[3]});
                        v0 = (f32x4){a.x, a.y, b.x, b.y}; v1 = (f32x4){c.x, c.y, d.x, d.y}; }
                    v0 = v0 * sc; v1 = v1 * sc; u32x4 w; w.x = cvt_pk_bf16(v0[0], v0[1]); w.y = cvt_pk_bf16(v0[2], v0[3]); w.z = cvt_pk_bf16(v1[0], v1[1]); w.w = cvt_pk_bf16(v1[2], v1[3]);
                    *(u32x4*)(rowp + bj * HALF) = w; } }
    }
};

template <class Epi, class Sched, bool ALIGN_EPI = false, bool SP2 = false>
__device__ __forceinline__ void gemm_phase(PG8_LAS unsigned char* lds, const Gemm g, const Sched& S, const Epi& E) {
    const int tid = threadIdx.x, wid = __builtin_amdgcn_readfirstlane(tid >> 6), lane = tid & 63, wr = wid >> 2, wc = wid & 3, fr = lane & 15, fq = lane >> 4;
    const int K = g.K, nt = K / BK;
    unsigned voffA[2], voffB[2];
#pragma unroll
    for (int i = 0; i < 2; ++i) { int R, C; stage_rc(tid * 16 + i * 8192, R, C); const int Rb = Epi::PERM ? ((R & ~31) + perm32(R & 31)) : R;
        voffA[i] = (unsigned)(R * K + C) * 2u; voffB[i] = (unsigned)(Rb * K + C) * 2u; }
    const size_t kstep = (size_t)(BK * 2);
    const size_t hstep = (size_t)HALF * K * 2;
    const size_t tstep = 2 * hstep;
    const unsigned ldsw = (unsigned)wid * 1024u;
    const int aoff = lds_byte(wr * 64 + fr, fq * 8), boff = lds_byte(wc * 32 + fr, fq * 8);
#define PG8_SA(b, h) (((b) * 2 + (h)) * HTB)
#define PG8_SB(b, h) ((4 + (b) * 2 + (h)) * HTB)
#define PG8_STAGE(bufoff, gbase, voff) do { _Pragma("unroll") for (int _i = 0; _i < 2; ++_i) \
        __builtin_amdgcn_global_load_lds((const unsigned*)((const char*)(gbase) + (voff)[_i]), (PG8_LAS unsigned*)(lds + (bufoff) + ldsw + _i * 8192), 16, 0, 0); } while (0)
#define PG8_LDA(dst, b, h) do { _Pragma("unroll") for (int m = 0; m < 4; ++m) _Pragma("unroll") for (int k = 0; k < 2; ++k) dst[m][k] = *(const PG8_LAS bf16x8*)(lds + PG8_SA(b, h) + aoff + m * 2048 + k * 1024); } while (0)
#define PG8_LDB(dst, b, h) do { _Pragma("unroll") for (int n = 0; n < 2; ++n) _Pragma("unroll") for (int k = 0; k < 2; ++k) dst[n][k] = *(const PG8_LAS bf16x8*)(lds + PG8_SB(b, h) + boff + n * 2048 + k * 1024); } while (0)
#define PG8_MMA(ai, bj, At, Bt) do { __builtin_amdgcn_s_setprio(1); _Pragma("unroll") for (int m = 0; m < 4; ++m) _Pragma("unroll") for (int n = 0; n < 2; ++n) _Pragma("unroll") for (int k = 0; k < 2; ++k) \
        acc[ai][bj][m][n] = __builtin_amdgcn_mfma_f32_16x16x32_bf16(Bt[n][k], At[m][k], acc[ai][bj][m][n], 0, 0, 0); __builtin_amdgcn_s_setprio(0); } while (0)
#define PG8_WAIT_V(n) asm volatile("s_waitcnt vmcnt(" #n ")" ::: "memory")
#define PG8_WAIT_L(n) asm volatile("s_waitcnt lgkmcnt(" #n ")" ::: "memory")
#define PG8_BAR __builtin_amdgcn_s_barrier()
#define PG8_SCHED __builtin_amdgcn_sched_barrier(0)
    Unit cur, nxt; int ui = 0;
    if (!S.next(0, cur)) return;
    f32x4 acc[2][2][4][2];
#pragma unroll
    for (int a = 0; a < 2; ++a)
#pragma unroll
        for (int b = 0; b < 2; ++b)
#pragma unroll
            for (int m = 0; m < 4; ++m)
#pragma unroll
                for (int n = 0; n < 2; ++n) acc[a][b][m][n] = (f32x4){0.f, 0.f, 0.f, 0.f};
    bf16x8 At[4][2], B0[2][2], B1[2][2];
    const char* cA = (const char*)g.A + (size_t)cur.pm * tstep; const char* cB = (const char*)g.Bt + (size_t)cur.pn * tstep;
    S.a_ready(cur);
    if constexpr (SP2) {
        PG8_STAGE(PG8_SB(0, 0), cB, voffB); PG8_STAGE(PG8_SB(0, 1), cB + hstep, voffB); PG8_STAGE(PG8_SA(0, 0), cA, voffA); PG8_STAGE(PG8_SA(0, 1), cA + hstep, voffA);
        if (wr == 1) PG8_BAR;
        PG8_WAIT_V(2); PG8_BAR;
        PG8_STAGE(PG8_SB(1, 0), cB + kstep, voffB); PG8_STAGE(PG8_SA(1, 0), cA + kstep, voffA); PG8_STAGE(PG8_SB(1, 1), cB + hstep + kstep, voffB);
        PG8_WAIT_V(6); PG8_BAR;
    } else {
        PG8_STAGE(PG8_SB(0, 0), cB, voffB); PG8_STAGE(PG8_SA(0, 0), cA, voffA); PG8_STAGE(PG8_SB(0, 1), cB + hstep, voffB); PG8_STAGE(PG8_SA(0, 1), cA + hstep, voffA);
        if (wr == 1) PG8_BAR;
        PG8_WAIT_V(4); PG8_BAR;
        PG8_STAGE(PG8_SB(1, 0), cB + kstep, voffB); PG8_STAGE(PG8_SA(1, 0), cA + kstep, voffA); PG8_STAGE(PG8_SB(1, 1), cB + hstep + kstep, voffB);
        PG8_WAIT_V(6); PG8_BAR;
    }
    for (;;) {
        const bool has_next = S.next(ui + 1, nxt);
        const char* nA = has_next ? (const char*)g.A + (size_t)nxt.pm * tstep : cA; const char* nB = has_next ? (const char*)g.Bt + (size_t)nxt.pn * tstep : cB;
        for (int t = 0; t < nt; t += 2) {
            const bool last = (t == nt - 2);
            const char* a1 = cA + (size_t)(t + 1) * kstep;
            const char* a2 = last ? nA : cA + (size_t)(t + 2) * kstep; const char* b2 = last ? nB : cB + (size_t)(t + 2) * kstep;
            const char* a3 = a2 + kstep; const char* b3 = b2 + kstep;
            if (last && has_next) S.a_ready(nxt);
            if constexpr (SP2) {
            PG8_LDB(B0, 0, 0); PG8_LDB(B1, 0, 1); PG8_SCHED; PG8_LDA(At, 0, 0); PG8_STAGE(PG8_SA(1, 1), a1 + hstep, voffA);
            PG8_WAIT_V(8); PG8_WAIT_L(0); PG8_BAR; PG8_MMA(0, 0, At, B0); PG8_MMA(0, 1, At, B1); PG8_BAR; PG8_SCHED;
            PG8_LDA(At, 0, 1); PG8_STAGE(PG8_SB(0, 0), b2, voffB); PG8_STAGE(PG8_SB(0, 1), b2 + hstep, voffB); PG8_STAGE(PG8_SA(0, 0), a2, voffA);
            PG8_WAIT_V(8); PG8_WAIT_L(0); PG8_BAR; PG8_MMA(1, 0, At, B0); PG8_MMA(1, 1, At, B1); PG8_BAR; PG8_SCHED;
            PG8_LDB(B0, 1, 0); PG8_LDB(B1, 1, 1); PG8_SCHED; PG8_LDA(At, 1, 0); PG8_STAGE(PG8_SA(0, 1), a2 + hstep, voffA);
            PG8_WAIT_V(8); PG8_WAIT_L(0); PG8_BAR; PG8_MMA(0, 0, At, B0); PG8_MMA(0, 1, At, B1); PG8_BAR; PG8_SCHED;
            PG8_LDA(At, 1, 1); PG8_STAGE(PG8_SB(1, 0), b3, voffB); PG8_STAGE(PG8_SB(1, 1), b3 + hstep, voffB); PG8_STAGE(PG8_SA(1, 0), a3, voffA);
            PG8_WAIT_V(8); PG8_WAIT_L(0); PG8_BAR; PG8_MMA(1, 0, At, B0); PG8_MMA(1, 1, At, B1); PG8_BAR; PG8_SCHED;
            } else {
            PG8_LDB(B0, 0, 0); PG8_SCHED; PG8_LDA(At, 0, 0); PG8_STAGE(PG8_SA(1, 1), a1 + hstep, voffA);
            PG8_WAIT_L(8); PG8_BAR; PG8_WAIT_L(0); PG8_MMA(0, 0, At, B0); PG8_BAR; PG8_SCHED;
            PG8_LDB(B1, 0, 1); PG8_STAGE(PG8_SB(0, 0), b2, voffB);
            PG8_BAR; PG8_WAIT_L(0); PG8_MMA(0, 1, At, B1); PG8_BAR;
            PG8_LDA(At, 0, 1); PG8_STAGE(PG8_SA(0, 0), a2, voffA);
            PG8_BAR; PG8_WAIT_L(0); PG8_MMA(1, 0, At, B0); PG8_BAR; PG8_SCHED;
            PG8_STAGE(PG8_SB(0, 1), b2 + hstep, voffB);
            PG8_WAIT_V(6); PG8_BAR; PG8_MMA(1, 1, At, B1); PG8_BAR;
            PG8_LDB(B0, 1, 0); PG8_SCHED; PG8_LDA(At, 1, 0); PG8_STAGE(PG8_SA(0, 1), a2 + hstep, voffA);
            PG8_WAIT_L(8); PG8_BAR; PG8_WAIT_L(0); PG8_MMA(0, 0, At, B0); PG8_BAR; PG8_SCHED;
            PG8_LDB(B1, 1, 1); PG8_STAGE(PG8_SB(1, 0), b3, voffB);
            PG8_BAR; PG8_WAIT_L(0); PG8_MMA(0, 1, At, B1); PG8_BAR;
            PG8_LDA(At, 1, 1); PG8_STAGE(PG8_SA(1, 0), a3, voffA);
            PG8_BAR; PG8_WAIT_L(0); PG8_MMA(1, 0, At, B0); PG8_BAR; PG8_SCHED;
            PG8_STAGE(PG8_SB(1, 1), b3 + hstep, voffB);
            PG8_WAIT_V(6); PG8_BAR; PG8_MMA(1, 1, At, B1); PG8_BAR;
            }
        }
        if constexpr (ALIGN_EPI) { if (wr == 0) PG8_BAR; }
        if constexpr (!Epi::AFTER_DRAIN) { E(acc, cur, wr, wc, fr, fq); S.done(cur); }
        if (!has_next) break;
#pragma unroll
        for (int a = 0; a < 2; ++a)
#pragma unroll
            for (int b = 0; b < 2; ++b)
#pragma unroll
                for (int m = 0; m < 4; ++m)
#pragma unroll
                    for (int n = 0; n < 2; ++n) acc[a][b][m][n] = (f32x4){0.f, 0.f, 0.f, 0.f};
        cur = nxt; cA = nA; cB = nB; ++ui;
        if constexpr (ALIGN_EPI) { if (wr == 1) PG8_BAR; }
    }
    PG8_WAIT_V(0);
    if constexpr (!ALIGN_EPI) { if (wr == 0) PG8_BAR; }
    PG8_BAR;
    if constexpr (Epi::AFTER_DRAIN) { E.fused(acc, cur, wr, wc, fr, fq, lds, wid, lane); S.done(cur); }
#undef PG8_SA
#undef PG8_SB
#undef PG8_STAGE
#undef PG8_LDA
#undef PG8_LDB
#undef PG8_MMA
#undef PG8_WAIT_V
#undef PG8_WAIT_L
#undef PG8_BAR
#undef PG8_SCHED
}
}
#define GAS __attribute__((address_space(1)))
#define LAS __attribute__((address_space(3)))
typedef unsigned short bf16;
typedef unsigned v4u __attribute__((ext_vector_type(4)));
typedef float f32x4 __attribute__((ext_vector_type(4)));
typedef short bf16x8 __attribute__((ext_vector_type(8)));
typedef GAS unsigned gu32;
typedef GAS unsigned long long gu64;
#define RLX_AGENT __ATOMIC_RELAXED, __HIP_MEMORY_SCOPE_AGENT
#define LDS_WAIT() asm volatile("s_waitcnt lgkmcnt(0)" ::: "memory")
#define VM_WAIT() asm volatile("s_waitcnt vmcnt(0)" ::: "memory")
__device__ __forceinline__ unsigned long long rt() { return __builtin_amdgcn_s_memrealtime(); }
__device__ __forceinline__ unsigned f2bf(float f) { unsigned u = __builtin_bit_cast(unsigned, f); return (u + 0x7fffu + ((u >> 16) & 1u)) >> 16; }
__device__ __forceinline__ unsigned pk2(float lo, float hi) { return f2bf(lo) | (f2bf(hi) << 16); }

#define XB_TMO      128
#define XB_XCNT(j)  (256  + 64 * (j))
#define XB_XSUB(j)  (1280 + 64 * (j))
#define XB_XGEN(j)  (2304 + 64 * (j))
#define XB_TOP      3328
#define XB_TOPGEN   3392
#define XCD_BAR_WORDS 3456
#define XB_SPIN_CAP (1u << 20)

__device__ __forceinline__ unsigned xb_ld(unsigned* p)              { return __hip_atomic_load(p, __ATOMIC_RELAXED, __HIP_MEMORY_SCOPE_AGENT); }
__device__ __forceinline__ unsigned xb_add(unsigned* p, unsigned v) { return __hip_atomic_fetch_add(p, v, __ATOMIC_RELAXED, __HIP_MEMORY_SCOPE_AGENT); }
__device__ __forceinline__ unsigned xb_xcc_id() { return (unsigned)__builtin_amdgcn_s_getreg((3 << 11) | 20) & 0xFu; }
#define XB_SPIN(cond, bar) do { unsigned _sp = 0; while (cond) { __builtin_amdgcn_s_sleep(1); \
    if ((++_sp & 255u) == 0u) { if (xb_ld(&(bar)[XB_TMO])) break; if (_sp > XB_SPIN_CAP) { atomicAdd(&(bar)[XB_TMO], 1u); break; } } } } while (0)

struct XcdBarrier {
    unsigned* bar; unsigned x;
    volatile LAS unsigned* st;
};

__device__ __forceinline__ XcdBarrier xcd_barrier_post(unsigned* bar, volatile LAS unsigned* st) {
    XcdBarrier b; b.bar = bar; b.x = xb_xcc_id(); b.st = st;
    if (threadIdx.x == 0) (void)xb_add(&bar[XB_XCNT(b.x)], 1u);
    return b;
}
__device__ __forceinline__ void xcd_barrier_complete(unsigned* bar, unsigned x, unsigned& nloc, unsigned& nx) {
    const unsigned G = gridDim.x * gridDim.y * gridDim.z;
    unsigned sum, cnt, mine, sp = 0u;
    for (;;) {
        sum = 0u; cnt = 0u; mine = 0u;
#pragma unroll
        for (unsigned j = 0; j < 16; ++j) { const unsigned c = xb_ld(&bar[XB_XCNT(j)]); sum += c; cnt += (c > 0u) ? 1u : 0u; mine = (j == x) ? c : mine; }
        if (sum == G) break;
        __builtin_amdgcn_s_sleep(1);
        if ((++sp & 255u) == 0u) { if (xb_ld(&bar[XB_TMO])) break; if (sp > XB_SPIN_CAP) { atomicAdd(&bar[XB_TMO], 1u); break; } }
    }
    nloc = mine > 0u ? mine : 1u; nx = cnt > 0u ? cnt : 1u;
}

__device__ __forceinline__ void xcd_barrier(const XcdBarrier& b) {
    asm volatile("s_waitcnt vmcnt(0)" ::: "memory");
    __syncthreads();
    if (threadIdx.x == 0) {
        unsigned* bar = b.bar;
        __builtin_amdgcn_s_waitcnt(0);
        unsigned nloc = b.st[0], nx = b.st[1];
        if (nloc == 0u) { xcd_barrier_complete(bar, b.x, nloc, nx); b.st[0] = nloc; b.st[1] = nx; }
        const unsigned old = xb_add(&bar[XB_XSUB(b.x)], 1u);
        const unsigned gen = old / nloc;
        if (old + 1u == (gen + 1u) * nloc) {
            __builtin_amdgcn_fence(__ATOMIC_RELEASE, "agent");
            asm volatile("s_waitcnt vmcnt(0)" ::: "memory");
            const unsigned og = xb_add(&bar[XB_TOP], 1u);
            const unsigned tg = og / nx;
            if (og + 1u == (tg + 1u) * nx) xb_add(&bar[XB_TOPGEN], 1u);
            else XB_SPIN(xb_ld(&bar[XB_TOPGEN]) == tg, bar);
            __builtin_amdgcn_fence(__ATOMIC_ACQUIRE, "agent");
            xb_add(&bar[XB_XGEN(b.x)], 1u);
            asm volatile("s_waitcnt vmcnt(0)" ::: "memory");
        } else {
            XB_SPIN(xb_ld(&bar[XB_XGEN(b.x)]) == gen, bar);
            __builtin_amdgcn_fence(__ATOMIC_ACQUIRE, "agent");
            asm volatile("s_waitcnt vmcnt(0)" ::: "memory");
        }
    }
    __syncthreads();
}

constexpr int NWAVES = 8;
constexpr int BATCH = 2, T = 8192, DM = 1024, M = BATCH * T;
constexpr int N0 = 4096, N1 = 3072;
constexpr int EVEN_IN = 3908, ODD_IN = 2976;
constexpr float NORM_EPS = 1e-6f;
constexpr int C0_AQ = 0, C0_AK = 512, C0_AV = 1024, C0_AG = 1536, C0_BQ = 2048, C0_BK = 2304, C0_BV = 2560, C0_BG = 3072, C0_IQ = 3584, C0_IK = 3840, C0_IW = 3904;
constexpr int C1_CQ = 0, C1_CK = 512, C1_CV = 1024, C1_CG = 1536, C1_DCQ = 2048, C1_DCKV = 2304, C1_DKR = 2432, C1_DG = 2464;

constexpr size_t MiB = 1u << 20;
constexpr size_t WS_CTL = 0, CTL_ZERO_BYTES = 1 * MiB;
constexpr size_t WS_W0T = 1 * MiB;
constexpr size_t WS_WO0T = 9 * MiB;
constexpr size_t WS_W1T = 11 * MiB;
constexpr size_t WS_WUQT = 17 * MiB;
constexpr size_t WS_WUKVT = 17 * MiB + 512 * 1024;
constexpr size_t WS_WO1T = 18 * MiB;
constexpr size_t WS_ROPE = 20 * MiB;
constexpr size_t WS_MASK = 26 * MiB;
constexpr size_t WS_U = 42 * MiB;
constexpr size_t WS_A = 58 * MiB;
constexpr size_t WS_B = 90 * MiB;
constexpr size_t WS_QD = 186 * MiB;
constexpr size_t WS_KVX = 218 * MiB;
constexpr size_t WS_KROPE = 250 * MiB;
constexpr size_t WS_END = 256 * MiB;
constexpr int CW_TMO = 0, CW_CODE = 1, CW_BAR = 4096;

constexpr int RING_OFF = 0, RING_BYTES = 131072;
constexpr int LDSCTL_OFF = RING_BYTES, MISC_OFF = LDSCTL_OFF + 320, INFO_OFF = LDSCTL_OFF + 1024;
constexpr int LDS_BYTES = 147456;

typedef float f32x16 __attribute__((ext_vector_type(16)));
typedef short s16x4 __attribute__((ext_vector_type(4)));
typedef unsigned u32x2 __attribute__((ext_vector_type(2)));

__device__ __forceinline__ float bf2f(bf16 b) { return __builtin_bit_cast(float, (unsigned)b << 16); }
__device__ __forceinline__ float bflo(unsigned w) { return __builtin_bit_cast(float, w << 16); }
__device__ __forceinline__ float bfhi(unsigned w) { return __builtin_bit_cast(float, w & 0xffff0000u); }
__device__ __forceinline__ float wave_sum(float v) {
#pragma unroll
    for (int o = 1; o < 64; o <<= 1) v += __shfl_xor(v, o);
    return v;
}
__device__ __forceinline__ float silu(float g) { return g / (1.0f + __expf(-g)); }
__device__ __forceinline__ f32x4 mfma16(bf16x8 a, bf16x8 b, f32x4 c) { return __builtin_amdgcn_mfma_f32_16x16x32_bf16(a, b, c, 0, 0, 0); }
__device__ __forceinline__ f32x16 mfma32(bf16x8 a, bf16x8 b, f32x16 c) { return __builtin_amdgcn_mfma_f32_32x32x16_bf16(a, b, c, 0, 0, 0); }

struct EpiF32 {
    static constexpr bool PERM = false, AFTER_DRAIN = false;
    float* O; int ldc;
    __device__ __forceinline__ void operator()(const pg8::f32x4 (&acc)[2][2][4][2], const pg8::Unit& u, int wr, int wc, int fr, int fq) const {
        const int row0 = u.pm * 256 + wr * 64 + fr, col0 = u.pn * 256 + wc * 32 + 4 * fq;
#pragma unroll
        for (int ai = 0; ai < 2; ++ai)
#pragma unroll
            for (int m = 0; m < 4; ++m) { float* rowp = O + (size_t)(row0 + ai * 128 + m * 16) * ldc + col0;
#pragma unroll
                for (int bj = 0; bj < 2; ++bj)
#pragma unroll
                    for (int n = 0; n < 2; ++n) *(pg8::f32x4*)(rowp + bj * 128 + n * 16) = acc[ai][bj][m][n]; }
    }
};

struct Frame {
    LAS unsigned char* lds;
    volatile LAS unsigned* MISC;
    gu32* ctl;
    int tid, lane, wave;
    int vcu, G;
    unsigned char* ws;
    const float* x; const int* pos; const float* pre_norm; const float* post_norm;
    const float *w_in_even, *w_out_even, *w_in_odd, *diff_lambda, *diff_subln, *q_norm, *kv_norm, *w_uq, *w_ukv, *w_out_odd;
    float* out;
};

__device__ __forceinline__ void sincos_acc(float ang, float& s_out, float& c_out) {
    const double a = (double)ang;
    const double k = __builtin_rint(a * 0.63661977236758134308);
    double r = __builtin_fma(-k, 1.57079632679489655800, a);
    r = __builtin_fma(-k, 6.12323399573676603587e-17, r);
    const float x = (float)r, x2 = x * x;
    const float s = x + x * x2 * (-1.6666667163e-1f + x2 * (8.3333337680e-3f + x2 * (-1.9841270114e-4f + x2 * 2.7557314297e-6f)));
    const float c = 1.0f - 0.5f * x2 + x2 * x2 * (4.1666667908e-2f + x2 * (-1.3888889225e-3f + x2 * (2.4801587642e-5f - x2 * 2.7557314297e-7f)));
    const int q = ((int)k) & 3;
    s_out = (q == 0) ? s : (q == 1) ? c : (q == 2) ? -s : -c;
    c_out = (q == 0) ? c : (q == 1) ? -s : (q == 2) ? -c : s;
}

template <int MAP>
__device__ __forceinline__ int src_col(int n, int Nsrc) {
    if (MAP == 1) { if (n < 2048) return n; if (n < 3584) return n + 324; if (n < 3908) return n - 1536; return -1; }
    return n < Nsrc ? n : -1;
}
template <int MAP>
__device__ __forceinline__ void p0_transpose_item(const float* W, int K, int Nsrc, int Ndst, bf16* WT, LAS float* scr, int item, int lane) {
    const int nblk = Ndst / 32, kb = item / nblk, nb = item % nblk, k0 = 64 * kb, n0 = 32 * nb;
    const int sc = src_col<MAP>(n0 + (lane & 31), Nsrc);
#pragma unroll 8
    for (int i = 0; i < 32; ++i) { const int kk = 2 * i + (lane >> 5); scr[kk * 33 + (lane & 31)] = sc >= 0 ? W[(size_t)(k0 + kk) * Nsrc + sc] : 0.0f; }
    LDS_WAIT(); asm volatile("" ::: "memory");
    const int c = lane & 7;
#pragma unroll
    for (int j = 0; j < 4; ++j) { const int n = (lane >> 3) + 8 * j; const LAS float* s = scr + (8 * c) * 33 + n;
        v4u o; o.x = pk2(s[0 * 33], s[1 * 33]); o.y = pk2(s[2 * 33], s[3 * 33]); o.z = pk2(s[4 * 33], s[5 * 33]); o.w = pk2(s[6 * 33], s[7 * 33]);
        *(GAS v4u*)(WT + (size_t)(n0 + n) * K + k0 + 8 * c) = o; }
    LDS_WAIT(); asm volatile("" ::: "memory");
}
__device__ __forceinline__ void rms_row_to_bf16(const float* xrow, const float* gain, bf16* orow, int lane) {
    const GAS f32x4* xr = (const GAS f32x4*)xrow + lane; const GAS f32x4* gr = (const GAS f32x4*)gain + lane;
    f32x4 v[4]; float s = 0.f;
#pragma unroll
    for (int j = 0; j < 4; ++j) { v[j] = xr[64 * j]; s += (v[j].x * v[j].x + v[j].y * v[j].y) + (v[j].z * v[j].z + v[j].w * v[j].w); }
    const float r = 1.0f / sqrtf(wave_sum(s) * (1.f / DM) + NORM_EPS);
    GAS unsigned long long* o8 = (GAS unsigned long long*)orow + lane;
#pragma unroll
    for (int j = 0; j < 4; ++j) { const f32x4 g = gr[64 * j];
        o8[64 * j] = (unsigned long long)pk2(v[j].x * r * g.x, v[j].y * r * g.y) | ((unsigned long long)pk2(v[j].z * r * g.z, v[j].w * r * g.w) << 32); }
}

__device__ __forceinline__ void p0_prologue(Frame& F) {
    LAS float* scr = (LAS float*)(F.lds + RING_OFF + F.wave * 16384);
    const int gw = F.vcu * NWAVES + F.wave, NGW = F.G * NWAVES;
    constexpr int I_W0 = (DM / 64) * (N0 / 32), I_WO = (DM / 64) * (DM / 32), I_W1 = (DM / 64) * (N1 / 32), I_UQ = (256 / 64) * (768 / 32), I_UKV = (128 / 64) * (1024 / 32);
    constexpr int NITEMS = I_W0 + I_WO + I_W1 + I_UQ + I_UKV + I_WO;
    for (int it = gw; it < NITEMS; it += NGW) {
        int r = it;
        if (r < I_W0) { p0_transpose_item<1>(F.w_in_even, DM, EVEN_IN, N0, (bf16*)(F.ws + WS_W0T), scr, r, F.lane); continue; } r -= I_W0;
        if (r < I_WO) { p0_transpose_item<0>(F.w_out_even, DM, DM, DM, (bf16*)(F.ws + WS_WO0T), scr, r, F.lane); continue; } r -= I_WO;
        if (r < I_W1) { p0_transpose_item<0>(F.w_in_odd, DM, ODD_IN, N1, (bf16*)(F.ws + WS_W1T), scr, r, F.lane); continue; } r -= I_W1;
        if (r < I_UQ) { p0_transpose_item<0>(F.w_uq, 256, 768, 768, (bf16*)(F.ws + WS_WUQT), scr, r, F.lane); continue; } r -= I_UQ;
        if (r < I_UKV) { p0_transpose_item<0>(F.w_ukv, 128, 1024, 1024, (bf16*)(F.ws + WS_WUKVT), scr, r, F.lane); continue; } r -= I_UKV;
        p0_transpose_item<0>(F.w_out_odd, DM, DM, DM, (bf16*)(F.ws + WS_WO1T), scr, r, F.lane);
    }
    {
        float* cosB = (float*)(F.ws + WS_ROPE); float* sinB = cosB + (size_t)M * 32; float* cosD = sinB + (size_t)M * 32; float* sinD = cosD + (size_t)M * 16;
        const int gt = F.vcu * (NWAVES * 64) + F.tid, NGT = F.G * NWAVES * 64;
        for (int e = gt; e < M * 48; e += NGT) {
            const int t = e / 48, i = e % 48;
            const float p = (float)F.pos[t];
            if (i < 32) { const float inv = (float)::exp2(-(double)i * (13.287712379549449 / 32.0)); float s, c; sincos_acc(p * inv, s, c); cosB[(size_t)t * 32 + i] = c; sinB[(size_t)t * 32 + i] = s; }
            else { const int ii = i - 32; const float inv = (float)::exp2(-(double)ii * (13.287712379549449 / 16.0)); float s, c; sincos_acc(p * inv, s, c); cosD[(size_t)t * 16 + ii] = c; sinD[(size_t)t * 16 + ii] = s; }
        }
    }
    for (int m = gw; m < M; m += NGW) rms_row_to_bf16(F.x + (size_t)m * DM, F.pre_norm, (bf16*)(F.ws + WS_A) + (size_t)m * DM, F.lane);
}

template <bool NEXT>
__device__ __forceinline__ void post_norm_rows(Frame& F, const float* xin, const float* mbuf, const float* gpost, const float* gpre, float* xout, bf16* hn) {
    const int gw = F.vcu * NWAVES + F.wave, NGW = F.G * NWAVES, lane = F.lane;
    for (int row = gw; row < M; row += NGW) {
        const GAS f32x4* mr = (const GAS f32x4*)(mbuf + (size_t)row * DM) + lane; const GAS f32x4* xr = (const GAS f32x4*)(xin + (size_t)row * DM) + lane;
        const GAS f32x4* gp = (const GAS f32x4*)gpost + lane;
        f32x4 mv[4], xv[4]; float s = 0.f;
#pragma unroll
        for (int j = 0; j < 4; ++j) { mv[j] = mr[64 * j]; xv[j] = xr[64 * j]; s += (mv[j].x * mv[j].x + mv[j].y * mv[j].y) + (mv[j].z * mv[j].z + mv[j].w * mv[j].w); }
        const float r = 1.0f / sqrtf(wave_sum(s) * (1.f / DM) + NORM_EPS);
        float s2 = 0.f;
#pragma unroll
        for (int j = 0; j < 4; ++j) { const f32x4 g = gp[64 * j]; xv[j] = xv[j] + (mv[j] * r) * g; s2 += (xv[j].x * xv[j].x + xv[j].y * xv[j].y) + (xv[j].z * xv[j].z + xv[j].w * xv[j].w); }
        GAS f32x4* xo = (GAS f32x4*)(xout + (size_t)row * DM) + lane;
#pragma unroll
        for (int j = 0; j < 4; ++j) xo[64 * j] = xv[j];
        if (NEXT) {
            const float r2 = 1.0f / sqrtf(wave_sum(s2) * (1.f / DM) + NORM_EPS);
            const GAS f32x4* gq = (const GAS f32x4*)gpre + lane; GAS unsigned long long* o8 = (GAS unsigned long long*)(hn + (size_t)row * DM) + lane;
#pragma unroll
            for (int j = 0; j < 4; ++j) { const f32x4 g = gq[64 * j];
                o8[64 * j] = (unsigned long long)pk2(xv[j].x * r2 * g.x, xv[j].y * r2 * g.y) | ((unsigned long long)pk2(xv[j].z * r2 * g.z, xv[j].w * r2 * g.w) << 32); }
        }
    }
}

__device__ __forceinline__ float ret_lg2_precise(int h) {
    return h == 0 ? -0.04580368961312479f : h == 1 ? -0.02272007650008353f : h == 2 ? -0.011315313227834146f : -0.005646563141142063f; }

__device__ __forceinline__ void ret_rot8(const bf16* src, const float* cosB, const float* sinB, size_t trow, int hcol, int d0, float scale, float (&o1)[8], float (&o2)[8]) {
    const bf16* kp = src + trow * N0 + hcol;
    const v4u x1 = *(const GAS v4u*)(kp + d0), x2 = *(const GAS v4u*)(kp + 32 + d0);
    const GAS f32x4* cp = (const GAS f32x4*)(cosB + trow * 32 + d0); const GAS f32x4* sp = (const GAS f32x4*)(sinB + trow * 32 + d0);
    const f32x4 c0 = cp[0], c1 = cp[1], s0 = sp[0], s1 = sp[1];
    const float co[8] = {c0.x, c0.y, c0.z, c0.w, c1.x, c1.y, c1.z, c1.w}, si[8] = {s0.x, s0.y, s0.z, s0.w, s1.x, s1.y, s1.z, s1.w};
    const unsigned w1[4] = {x1.x, x1.y, x1.z, x1.w}, w2[4] = {x2.x, x2.y, x2.z, x2.w};
#pragma unroll
    for (int e = 0; e < 8; ++e) {
        const float a = (e & 1) ? bfhi(w1[e >> 1]) : bflo(w1[e >> 1]), b = (e & 1) ? bfhi(w2[e >> 1]) : bflo(w2[e >> 1]);
        o1[e] = (a * co[e] - b * si[e]) * scale; o2[e] = (a * si[e] + b * co[e]) * scale;
    }
}

__device__ __forceinline__ void ret_u_item(Frame& F, int item) {
    int tid_o = F.tid; asm volatile("" : "+v"(tid_o));
    const int n = item & 63, h = (item >> 6) & 3, b = item >> 8, tid = tid_o, lane = tid & 63, wave = F.wave;
    LAS bf16* KT = (LAS bf16*)(F.lds + RING_OFF); LAS bf16* VT = KT + 64 * 136;
    const bf16* P = (const bf16*)(F.ws + WS_B);
    const float* cosB = (const float*)(F.ws + WS_ROPE); const float* sinB = cosB + (size_t)M * 32;
    const float lg2 = ret_lg2_precise(h);
    {
        const int j = tid >> 2, d0 = (tid & 3) * 8; const size_t trow = (size_t)b * T + n * 128 + j;
        float o1[8], o2[8]; ret_rot8(P, cosB, sinB, trow, C0_BK + h * 64, d0, 0.125f * __builtin_amdgcn_exp2f((float)(127 - j) * lg2), o1, o2);
#pragma unroll
        for (int e = 0; e < 8; ++e) { KT[(d0 + e) * 136 + j] = (bf16)f2bf(o1[e]); KT[(32 + d0 + e) * 136 + j] = (bf16)f2bf(o2[e]); }
    }
#pragma unroll
    for (int i = 0; i < 4; ++i) {
        const int p = tid + 512 * i, j = p >> 4, c = (p & 15) * 8; const size_t trow = (size_t)b * T + n * 128 + j;
        const v4u x = *(const GAS v4u*)(P + trow * N0 + C0_BV + h * 128 + c); const unsigned w[4] = {x.x, x.y, x.z, x.w};
#pragma unroll
        for (int e = 0; e < 8; ++e) VT[(c + e) * 136 + j] = (bf16)((e & 1) ? (w[e >> 1] >> 16) : (w[e >> 1] & 0xffffu));
    }
    __syncthreads();
    const int dt = wave & 3, et0 = (wave >> 2) * 4, fr = lane & 15, fq = lane >> 4;
    f32x4 acc[4];
#pragma unroll
    for (int i = 0; i < 4; ++i) acc[i] = (f32x4){0.f, 0.f, 0.f, 0.f};
#pragma unroll
    for (int ks = 0; ks < 4; ++ks) {
        const bf16x8 a = *(const LAS bf16x8*)(KT + (16 * dt + fr) * 136 + 32 * ks + 8 * fq);
#pragma unroll
        for (int nt = 0; nt < 4; ++nt) { const bf16x8 bb = *(const LAS bf16x8*)(VT + (16 * (et0 + nt) + fr) * 136 + 32 * ks + 8 * fq); acc[nt] = mfma16(a, bb, acc[nt]); }
    }
    float* U = (float*)(F.ws + WS_U) + (size_t)((b * 4 + h) * 64 + n) * 8192;
#pragma unroll
    for (int nt = 0; nt < 4; ++nt)
#pragma unroll
        for (int r = 0; r < 4; ++r) U[(16 * dt + 4 * fq + r) * 128 + 16 * (et0 + nt) + fr] = acc[nt][r];
    __syncthreads();
}

__device__ __forceinline__ void ret_scan(Frame& F) {
    const int gt = F.vcu * (NWAVES * 64) + F.tid, NGT = F.G * NWAVES * 64;
    for (int e = gt; e < 8 * 8192; e += NGT) {
        const int bh = e >> 13, de = e & 8191, h = bh & 3;
        const float gch = __builtin_amdgcn_exp2f(128.0f * ret_lg2_precise(h));
        float* U = (float*)(F.ws + WS_U) + (size_t)bh * 64 * 8192 + de;
        float S = 0.f;
        for (int n0 = 0; n0 < 64; n0 += 8) {
            float v[8];
#pragma unroll
            for (int k = 0; k < 8; ++k) v[k] = U[(size_t)(n0 + k) * 8192];
#pragma unroll
            for (int k = 0; k < 8; ++k) { U[(size_t)(n0 + k) * 8192] = S; S = gch * S + v[k]; }
        }
    }
}

__device__ __forceinline__ void ret_out_item(Frame& F, int item) {
    int tid_o = F.tid; asm volatile("" : "+v"(tid_o));
    const int n = item & 63, h = (item >> 6) & 3, b = item >> 8, tid = tid_o, lane = tid & 63, wave = F.wave;
    LAS bf16* Qs = (LAS bf16*)(F.lds + RING_OFF); LAS bf16* Ks = Qs + 128 * 72; LAS bf16* VT = Ks + 128 * 72; LAS bf16* ST = VT + 128 * 136; LAS bf16* Ps = ST + 128 * 72;
    const bf16* P = (const bf16*)(F.ws + WS_B);
    const float* cosB = (const float*)(F.ws + WS_ROPE); const float* sinB = cosB + (size_t)M * 32;
    const float lg2 = ret_lg2_precise(h);
    {
        const int j = tid >> 2, d0 = (tid & 3) * 8; const size_t trow = (size_t)b * T + n * 128 + j;
        float o1[8], o2[8];
        ret_rot8(P, cosB, sinB, trow, C0_BQ + h * 64, d0, 1.0f, o1, o2);
        *(LAS v4u*)(Qs + j * 72 + d0) = (v4u){pk2(o1[0], o1[1]), pk2(o1[2], o1[3]), pk2(o1[4], o1[5]), pk2(o1[6], o1[7])};
        *(LAS v4u*)(Qs + j * 72 + 32 + d0) = (v4u){pk2(o2[0], o2[1]), pk2(o2[2], o2[3]), pk2(o2[4], o2[5]), pk2(o2[6], o2[7])};
        ret_rot8(P, cosB, sinB, trow, C0_BK + h * 64, d0, 0.125f, o1, o2);
        *(LAS v4u*)(Ks + j * 72 + d0) = (v4u){pk2(o1[0], o1[1]), pk2(o1[2], o1[3]), pk2(o1[4], o1[5]), pk2(o1[6], o1[7])};
        *(LAS v4u*)(Ks + j * 72 + 32 + d0) = (v4u){pk2(o2[0], o2[1]), pk2(o2[2], o2[3]), pk2(o2[4], o2[5]), pk2(o2[6], o2[7])};
    }
#pragma unroll
    for (int i = 0; i < 4; ++i) {
        const int p = tid + 512 * i, j = p >> 4, c = (p & 15) * 8; const size_t trow = (size_t)b * T + n * 128 + j;
        const v4u x = *(const GAS v4u*)(P + trow * N0 + C0_BV + h * 128 + c); const unsigned w[4] = {x.x, x.y, x.z, x.w};
#pragma unroll
        for (int e = 0; e < 8; ++e) VT[(c + e) * 136 + j] = (bf16)((e & 1) ? (w[e >> 1] >> 16) : (w[e >> 1] & 0xffffu));
    }
    {
        const float* U = (const float*)(F.ws + WS_U) + (size_t)((b * 4 + h) * 64 + n) * 8192;
#pragma unroll
        for (int i = 0; i < 4; ++i) {
            const int idx = tid + 512 * i, d = idx >> 5, e4 = (idx & 31) * 4;
            const f32x4 sv = *(const GAS f32x4*)(U + d * 128 + e4);
            ST[(e4 + 0) * 72 + d] = (bf16)f2bf(sv.x); ST[(e4 + 1) * 72 + d] = (bf16)f2bf(sv.y); ST[(e4 + 2) * 72 + d] = (bf16)f2bf(sv.z); ST[(e4 + 3) * 72 + d] = (bf16)f2bf(sv.w);
        }
    }
    __syncthreads();
    const int i0 = 16 * wave, fr = lane & 15, fq = lane >> 4;
    bf16x8 aq[2];
#pragma unroll
    for (int ks = 0; ks < 2; ++ks) aq[ks] = *(const LAS bf16x8*)(Qs + (i0 + fr) * 72 + 32 * ks + 8 * fq);
#pragma unroll
    for (int jt = 0; jt < 8; ++jt) {
        f32x4 acc = (f32x4){0.f, 0.f, 0.f, 0.f};
#pragma unroll
        for (int ks = 0; ks < 2; ++ks) { const bf16x8 bb = *(const LAS bf16x8*)(Ks + (16 * jt + fr) * 72 + 32 * ks + 8 * fq); acc = mfma16(aq[ks], bb, acc); }
#pragma unroll
        for (int r = 0; r < 4; ++r) { const int i = i0 + 4 * fq + r, j = 16 * jt + fr;
            const float dcy = (i >= j) ? __builtin_amdgcn_exp2f((float)(i - j) * lg2) : 0.f; Ps[i * 136 + j] = (bf16)f2bf(acc[r] * dcy); }
    }
    __syncthreads();
    f32x4 oi[8], oc[8];
#pragma unroll
    for (int et = 0; et < 8; ++et) { oi[et] = (f32x4){0.f, 0.f, 0.f, 0.f}; oc[et] = (f32x4){0.f, 0.f, 0.f, 0.f}; }
#pragma unroll
    for (int ks = 0; ks < 4; ++ks) {
        const bf16x8 ap = *(const LAS bf16x8*)(Ps + (i0 + fr) * 136 + 32 * ks + 8 * fq);
#pragma unroll
        for (int et = 0; et < 8; ++et) { const bf16x8 bb = *(const LAS bf16x8*)(VT + (16 * et + fr) * 136 + 32 * ks + 8 * fq); oi[et] = mfma16(ap, bb, oi[et]); }
    }
#pragma unroll
    for (int ks = 0; ks < 2; ++ks)
#pragma unroll
        for (int et = 0; et < 8; ++et) { const bf16x8 bb = *(const LAS bf16x8*)(ST + (16 * et + fr) * 72 + 32 * ks + 8 * fq); oc[et] = mfma16(aq[ks], bb, oc[et]); }
    bf16* MIX = (bf16*)(F.ws + WS_A);
#pragma unroll
    for (int r = 0; r < 4; ++r) {
        const int i = i0 + 4 * fq + r; const float xi = __builtin_amdgcn_exp2f((float)(i + 1) * lg2);
        float v[8]; float s = 0.f;
#pragma unroll
        for (int et = 0; et < 8; ++et) { v[et] = oi[et][r] + xi * oc[et][r]; s += v[et]; }
        s += __shfl_xor(s, 1); s += __shfl_xor(s, 2); s += __shfl_xor(s, 4); s += __shfl_xor(s, 8);
        const float mu = s * (1.f / 128.f); float q = 0.f;
#pragma unroll
        for (int et = 0; et < 8; ++et) { v[et] -= mu; q += v[et] * v[et]; }
        q += __shfl_xor(q, 1); q += __shfl_xor(q, 2); q += __shfl_xor(q, 4); q += __shfl_xor(q, 8);
        const float rstd = 1.0f / sqrtf(q * (1.f / 128.f) + NORM_EPS);
        const size_t trow = (size_t)b * T + n * 128 + i;
#pragma unroll
        for (int et = 0; et < 8; ++et) { const int e = 16 * et + fr; const float g = bf2f(P[trow * N0 + C0_BG + h * 128 + e]);
            MIX[trow * DM + 512 + h * 128 + e] = (bf16)f2bf(v[et] * rstd * silu(g)); }
    }
    __syncthreads();
}

constexpr int IDX_CAP = 768;
template <int PASS>
__device__ __forceinline__ void idx_pass(const bf16x8 (&qa)[4][4], const LAS f32x4* wtab, const bf16* Kb, int g, LAS unsigned* hist, LAS unsigned* info, LAS unsigned* lcnt, int wave, int lane) {
    const int r = lane & 31, hh = lane >> 5, ntile = g + 1;
    LAS unsigned* img = hist;
    LAS unsigned* lst = hist + 32 * 256;
    bf16x8 kb[4];
    int kt = wave;
    const unsigned klane = (unsigned)(r * N0 + 8 * hh);
    if (kt < ntile) { const bf16* kp = Kb + (size_t)(32 * kt) * N0;
#pragma unroll
        for (int ks = 0; ks < 4; ++ks) kb[ks] = *(const GAS bf16x8*)(kp + klane + 16 * ks); }
    for (; kt < ntile; kt += 8) {
        bf16x8 kn[4];
        if (kt + 8 < ntile) { const bf16* kp = Kb + (size_t)(32 * (kt + 8)) * N0;
#pragma unroll
            for (int ks = 0; ks < 4; ++ks) kn[ks] = *(const GAS bf16x8*)(kp + klane + 16 * ks); }
        else {
#pragma unroll
            for (int ks = 0; ks < 4; ++ks) kn[ks] = kb[ks]; }
        const int s = 32 * kt + r; const bool diag = (kt == g);
#pragma unroll
        for (int m = 0; m < 4; ++m) {
            f32x16 acc;
#pragma unroll
            for (int q = 0; q < 16; ++q) acc[q] = 0.f;
#pragma unroll
            for (int ks = 0; ks < 4; ++ks) acc = mfma32(qa[m][ks], kb[ks], acc);
#pragma unroll
            for (int i = 0; i < 4; ++i) {
                const f32x4 w4 = wtab[8 * m + 4 * hh + i];
                float sc = __builtin_fmaf(w4.x, __builtin_fmaxf(acc[i], 0.f), 0.0f);
                sc = __builtin_fmaf(w4.y, __builtin_fmaxf(acc[4 + i], 0.f), sc);
                sc = __builtin_fmaf(w4.z, __builtin_fmaxf(acc[8 + i], 0.f), sc);
                sc = __builtin_fmaf(w4.w, __builtin_fmaxf(acc[12 + i], 0.f), sc);
                const unsigned u = __builtin_bit_cast(unsigned, sc);
                unsigned key = u ^ ((unsigned)((int)u >> 31) | 0x80000000u);
                key = (key & 0xFFFFE000u) | (unsigned)(8191 - s);
                const int row = 8 * m + 4 * hh + i;
                const bool valid = !diag || (r <= row);
                if (PASS == 1) { if (valid) { const unsigned bin = key >> 21; __hip_atomic_fetch_add(hist + row * 1024 + (bin >> 1), 1u << ((bin & 1u) * 16u), __ATOMIC_RELAXED, __HIP_MEMORY_SCOPE_WORKGROUP); } }
                if (PASS == 2) { if (valid && (key >> 21) == info[row]) { const unsigned bin = (key >> 10) & 2047u; __hip_atomic_fetch_add(hist + row * 1024 + (bin >> 1), 1u << ((bin & 1u) * 16u), __ATOMIC_RELAXED, __HIP_MEMORY_SCOPE_WORKGROUP); } }
                if (PASS == 3) { if (valid && (key >> 10) == info[row]) { const unsigned bin = key & 1023u; __hip_atomic_fetch_add(hist + row * 1024 + (bin >> 1), 1u << ((bin & 1u) * 16u), __ATOMIC_RELAXED, __HIP_MEMORY_SCOPE_WORKGROUP); } }
                if (PASS == 5 || PASS == 6) {
                    bool def;
                    if (PASS == 5) { const unsigned k11 = key >> 21, b1 = info[row]; def = valid && (k11 > b1);
                        if (valid && (k11 == b1)) { const unsigned pos = __hip_atomic_fetch_add(lcnt + row, 1u, __ATOMIC_RELAXED, __HIP_MEMORY_SCOPE_WORKGROUP); lst[row * IDX_CAP + pos] = key; } }
                    else def = valid && (key >= info[row]);
                    const unsigned long long bm = __ballot(def);
                    if (lane == 0) { img[(8 * m + i) * 256 + kt] = (unsigned)bm; img[(8 * m + 4 + i) * 256 + kt] = (unsigned)(bm >> 32); }
                }
            }
            __builtin_amdgcn_sched_barrier(0);
        }
#pragma unroll
        for (int ks = 0; ks < 4; ++ks) kb[ks] = kn[ks];
    }
}

template <int L>
__device__ __forceinline__ void idx_scan(LAS unsigned* hist, LAS unsigned* info, LAS unsigned* need, LAS unsigned* ccnt, int wave, int lane) {
    constexpr int NB = (L == 3) ? 1024 : 2048, BPL = NB / 64, WPL = BPL / 2;
#pragma unroll 1
    for (int rr = 0; rr < 4; ++rr) {
        const int row = 4 * wave + rr;
        const LAS unsigned* hp = hist + row * 1024 + lane * WPL;
        unsigned wds[WPL]; unsigned cnt = 0u;
#pragma unroll
        for (int k = 0; k < WPL; ++k) { wds[k] = hp[k]; cnt += (wds[k] & 0xffffu) + (wds[k] >> 16); }
        unsigned x = cnt;
#pragma unroll
        for (int off = 1; off < 64; off <<= 1) { const unsigned y = (unsigned)__shfl_down((int)x, off); if (lane + off < 64) x += y; }
        const unsigned S = x - cnt, nd = need[row];
        const bool hit = (S < nd) && (S + cnt >= nd);
        unsigned run = S; int fb = -1; unsigned fn = 0u, fc = 0u;
#pragma unroll
        for (int bi = BPL - 1; bi >= 0; --bi) {
            const unsigned c = (bi & 1) ? (wds[bi >> 1] >> 16) : (wds[bi >> 1] & 0xffffu);
            const bool here = (fb < 0) && (run + c >= nd);
            if (here) { fb = bi; fn = nd - run; fc = c; }
            run += c;
        }
        if (hit) {
            const unsigned bin = (unsigned)(lane * BPL + fb);
            if (L == 1) { info[row] = bin; need[row] = fn; ccnt[row] = fc; }
            if (L == 2) { info[row] = (info[row] << 11) | bin; need[row] = fn; }
            if (L == 3) { info[row] = (info[row] << 10) | bin; }
        }
    }
}

__device__ __forceinline__ void idx_zero(LAS unsigned* p, int n16, int tid) {
    LAS v4u* h4 = (LAS v4u*)p;
    for (int i = tid; i < n16; i += 512) h4[i] = (v4u){0u, 0u, 0u, 0u};
}

__device__ __forceinline__ void idx_item(Frame& F, int b, int g) {
    LAS unsigned* hist = (LAS unsigned*)(F.lds + RING_OFF);
    LAS unsigned* info = (LAS unsigned*)(F.lds + INFO_OFF);
    LAS unsigned* need = info + 32; LAS unsigned* ccnt = info + 64; LAS unsigned* lcnt = info + 96;
    LAS f32x4* wtab = (LAS f32x4*)(info + 128);
    int tid_o = F.tid; asm volatile("" : "+v"(tid_o));
    const int tid = tid_o, lane = tid & 63, wave = F.wave, r = lane & 31, hh = lane >> 5;
    const bf16* Pb = (const bf16*)(F.ws + WS_B) + (size_t)b * T * N0;
    bf16x8 qa[4][4];
#pragma unroll
    for (int m = 0; m < 4; ++m) {
        const bf16* qp = Pb + (size_t)(32 * g + 8 * m + (r & 7)) * N0 + C0_IQ + (r >> 3) * 64 + 8 * hh;
#pragma unroll
        for (int ks = 0; ks < 4; ++ks) qa[m][ks] = *(const GAS bf16x8*)(qp + 16 * ks);
    }
    if (tid < 32) { const u32x2 wp = *(const GAS u32x2*)(Pb + (size_t)(32 * g + tid) * N0 + C0_IW); wtab[tid] = (f32x4){bflo(wp.x), bfhi(wp.x), bflo(wp.y), bfhi(wp.y)}; }
    const bf16* Kb = Pb + C0_IK;
    LAS unsigned* img = hist; LAS unsigned* lst = hist + 32 * 256;
    if (g >= 8) {
        idx_zero(hist, 8192, tid); if (tid < 32) { info[tid] = 0u; need[tid] = 256u; ccnt[tid] = 0u; lcnt[tid] = 0u; }
        __syncthreads();
        idx_pass<1>(qa, wtab, Kb, g, hist, info, lcnt, wave, lane);
        __syncthreads();
        idx_scan<1>(hist, info, need, ccnt, wave, lane);
        __syncthreads();
        unsigned cmax = 0u;
#pragma unroll
        for (int i = 0; i < 32; ++i) cmax = max(cmax, ccnt[i]);
        const bool fast = (unsigned)__builtin_amdgcn_readfirstlane((int)cmax) <= (unsigned)IDX_CAP;
        __syncthreads();
        if (fast) {
            idx_zero(img, 2048, tid);
            __syncthreads();
            idx_pass<5>(qa, wtab, Kb, g, hist, info, lcnt, wave, lane);
            __syncthreads();
#pragma unroll 1
            for (int rr = 0; rr < 4; ++rr) {
                const int row = 4 * wave + rr;
                const unsigned n = lcnt[row], nd = need[row]; unsigned prefix = info[row] << 21;
                const LAS unsigned* lp = lst + row * IDX_CAP;
#pragma unroll 1
                for (int bit = 20; bit >= 0; --bit) {
                    const unsigned cand = prefix | (1u << bit); unsigned c = 0u;
                    for (unsigned j0 = 0; j0 < n; j0 += 64) { const unsigned j = j0 + lane; const unsigned k = (j < n) ? lp[j] : 0u; c += (unsigned)__popcll(__ballot(k >= cand)); }
                    if (c >= nd) prefix = cand;
                }
                for (unsigned j0 = 0; j0 < n; j0 += 64) { const unsigned j = j0 + lane;
                    if (j < n) { const unsigned k = lp[j]; if (k >= prefix) { const unsigned s = 8191u - (k & 8191u);
                        __hip_atomic_fetch_or(img + row * 256 + (s >> 5), 1u << (s & 31u), __ATOMIC_RELAXED, __HIP_MEMORY_SCOPE_WORKGROUP); } } }
            }
        } else {
            idx_zero(hist, 8192, tid);
            __syncthreads();
            idx_pass<2>(qa, wtab, Kb, g, hist, info, lcnt, wave, lane);
            __syncthreads();
            idx_scan<2>(hist, info, need, ccnt, wave, lane);
            __syncthreads();
            idx_zero(hist, 8192, tid);
            __syncthreads();
            idx_pass<3>(qa, wtab, Kb, g, hist, info, lcnt, wave, lane);
            __syncthreads();
            idx_scan<3>(hist, info, need, ccnt, wave, lane);
            __syncthreads();
            idx_zero(img, 2048, tid);
            __syncthreads();
            idx_pass<6>(qa, wtab, Kb, g, hist, info, lcnt, wave, lane);
        }
    } else {
        idx_zero(img, 2048, tid); if (tid < 32) info[tid] = 0u;
        __syncthreads();
        idx_pass<6>(qa, wtab, Kb, g, hist, info, lcnt, wave, lane);
    }
    __syncthreads();
    { v4u* dst = (v4u*)((unsigned*)(F.ws + WS_MASK) + ((size_t)b * T + 32 * g) * 256); const LAS v4u* src = (const LAS v4u*)img;
#pragma unroll
      for (int i = 0; i < 4; ++i) dst[tid + 512 * i] = src[tid + 512 * i]; }
    __syncthreads();
}

namespace att {
#define SBAR() __builtin_amdgcn_sched_barrier(0)
__device__ __forceinline__ int crow(int r, int hi) { return (r & 3) + 8 * (r >> 2) + 4 * hi; }
__device__ __forceinline__ unsigned cvtpk(float lo, float hi) { unsigned r; asm volatile("v_cvt_pk_bf16_f32 %0, %1, %2" : "=v"(r) : "v"(lo), "v"(hi)); return r; }
constexpr float THR_NAT = 8.0f;

__device__ __forceinline__ void partialSM(f32x16& p0, f32x16& p1, float& m_reg, float& mn, float& alpha, float C, float thr_raw) {
    float pmax = p0[0];
#pragma unroll
    for (int r = 1; r < 16; ++r) pmax = fmaxf(pmax, p0[r]);
#pragma unroll
    for (int r = 0; r < 16; ++r) pmax = fmaxf(pmax, p1[r]);
    { auto rr = __builtin_amdgcn_permlane32_swap(__float_as_uint(pmax), __float_as_uint(pmax), false, false);
      pmax = fmaxf(__uint_as_float(rr[0]), __uint_as_float(rr[1])); }
    if (__builtin_expect(__all(pmax - m_reg <= thr_raw), 1)) { mn = m_reg; alpha = 1.f; }
    else { mn = fmaxf(m_reg, pmax); alpha = __builtin_amdgcn_exp2f((m_reg - mn) * C); m_reg = mn; }
    const float mnC = -mn * C;
#pragma unroll
    for (int r = 0; r < 16; ++r) p0[r] = fmaf(p0[r], C, mnC);
#pragma unroll
    for (int r = 0; r < 16; ++r) p1[r] = fmaf(p1[r], C, mnC);
#pragma unroll
    for (int r = 0; r < 16; ++r) p0[r] = __builtin_amdgcn_exp2f(p0[r]);
}
__device__ __forceinline__ void finishSM(f32x16& p0, f32x16& p1, float alpha, float& l_reg, bf16x8& pa0, bf16x8& pa1, bf16x8& pa2, bf16x8& pa3) {
#pragma unroll
    for (int r = 0; r < 16; ++r) p1[r] = __builtin_amdgcn_exp2f(p1[r]);
    float ps = 0;
#pragma unroll
    for (int r = 0; r < 16; ++r) ps += p0[r];
#pragma unroll
    for (int r = 0; r < 16; ++r) ps += p1[r];
    { auto rr = __builtin_amdgcn_permlane32_swap(__float_as_uint(ps), __float_as_uint(ps), false, false);
      ps = __uint_as_float(rr[0]) + __uint_as_float(rr[1]); }
    l_reg = l_reg * alpha + ps;
#define PK4(P, BASE, OUT) do { unsigned a0 = cvtpk(P[BASE + 0], P[BASE + 1]), a1 = cvtpk(P[BASE + 2], P[BASE + 3]);   \
    unsigned b0 = cvtpk(P[BASE + 4], P[BASE + 5]), b1 = cvtpk(P[BASE + 6], P[BASE + 7]);                              \
    auto r0 = __builtin_amdgcn_permlane32_swap(a0, b0, false, false); auto r1 = __builtin_amdgcn_permlane32_swap(a1, b1, false, false); \
    v4u w = {r0[0], r1[0], r0[1], r1[1]}; OUT = __builtin_bit_cast(bf16x8, w); } while (0)
    PK4(p0, 0, pa0); PK4(p0, 8, pa1); PK4(p1, 0, pa2); PK4(p1, 8, pa3);
#undef PK4
}
template <int ND0, bool MASKED>
__device__ __forceinline__ void qkt(f32x16& p0, f32x16& p1, const LAS char* Kb, const bf16x8 (&qr)[ND0], int r32, int hi, u32x2 mw) {
    if constexpr (MASKED) {
        const unsigned x0 = (~mw.x) >> (4 * hi), x1 = (~mw.y) >> (4 * hi);
#pragma unroll
        for (int q = 0; q < 16; ++q) { const int c = (q & 3) + 8 * (q >> 2);
            p0[q] = __builtin_bit_cast(float, (unsigned)__builtin_amdgcn_sbfe((int)x0, c, 1) & 0xFF800000u);
            p1[q] = __builtin_bit_cast(float, (unsigned)__builtin_amdgcn_sbfe((int)x1, c, 1) & 0xFF800000u); }
    } else {
#pragma unroll
        for (int q = 0; q < 16; ++q) { p0[q] = 0.f; p1[q] = 0.f; }
    }
#pragma unroll
    for (int d0 = 0; d0 < ND0; ++d0) {
        const bf16x8 b0 = *(const LAS bf16x8*)(Kb + (2 * d0 + hi) * 1024 + r32 * 16);
        const bf16x8 b1 = *(const LAS bf16x8*)(Kb + (2 * d0 + hi) * 1024 + (32 + r32) * 16);
        p0 = mfma32(b0, qr[d0], p0);
        p1 = mfma32(b1, qr[d0], p1); }
}
template <int NCB> __device__ __forceinline__ int v_st(int k, int c) { const int kk = (k & ~0xC) | ((k & 4) << 1) | ((k & 8) >> 1); return ((kk >> 3) * NCB + (c >> 5)) * 512 + ((kk & 7) * 32 + (c & 31)) * 2; }
__device__ __forceinline__ int v_rd_base(int lane) { return ((lane & 3) << 3) | (((lane >> 2) & 3) << 6) | (((lane >> 4) & 1) << 5) | (((lane >> 5) & 1) << 8); }
template <int OFF> __device__ __forceinline__ s16x4 tr_read(int vb) { s16x4 r; asm volatile("ds_read_b64_tr_b16 %0, %1 offset:%2" : "=&v"(r) : "v"(vb), "i"(OFF) : "memory"); return r; }
template <int NCB, int D0> __device__ __forceinline__ void pv_one(f32x16& od, int vb, bf16x8 pa0, bf16x8 pa1, bf16x8 pa2, bf16x8 pa3) {
    constexpr int KS = NCB * 1024, HF = NCB * 512, B0 = D0 * 512;
    const s16x4 l0 = tr_read<B0>(vb), h0 = tr_read<B0 + HF>(vb), l1 = tr_read<B0 + KS>(vb), h1 = tr_read<B0 + KS + HF>(vb);
    const s16x4 l2 = tr_read<B0 + 2 * KS>(vb), h2 = tr_read<B0 + 2 * KS + HF>(vb), l3 = tr_read<B0 + 3 * KS>(vb), h3 = tr_read<B0 + 3 * KS + HF>(vb);
    asm volatile("s_waitcnt lgkmcnt(0)" ::: "memory"); SBAR();
#define PK(L, H) (bf16x8){L[0], L[1], L[2], L[3], H[0], H[1], H[2], H[3]}
    od = mfma32(pa0, PK(l0, h0), od);
    od = mfma32(pa1, PK(l1, h1), od);
    od = mfma32(pa2, PK(l2, h2), od);
    od = mfma32(pa3, PK(l3, h3), od);
#undef PK
}
template <int NCB> __device__ __forceinline__ void pv_all(f32x16 (&o)[NCB], int vb, bf16x8 pa0, bf16x8 pa1, bf16x8 pa2, bf16x8 pa3) {
    pv_one<NCB, 0>(o[0], vb, pa0, pa1, pa2, pa3); pv_one<NCB, 1>(o[1], vb, pa0, pa1, pa2, pa3);
    if constexpr (NCB == 4) { pv_one<NCB, 2>(o[2], vb, pa0, pa1, pa2, pa3); pv_one<NCB, 3>(o[3], vb, pa0, pa1, pa2, pa3); }
}
__device__ __forceinline__ void cmask(f32x16& p0, f32x16& p1, int jb, int qrel, int hi) {
    const float NEG = -INFINITY; const int d = qrel - 64 * jb - 4 * hi;
#pragma unroll
    for (int r = 0; r < 16; ++r) { const int c = (r & 3) + 8 * (r >> 2); if (c > d) p0[r] = NEG; if (c + 32 > d) p1[r] = NEG; }
}
struct AttnP {
    const bf16* Q; const bf16* K; const bf16* K2; const bf16* V; bf16* O; const bf16* G; const unsigned* mask; const float* cs; const float* sn;
    int ldq, ldk, ldk2, ldv, ldo, ldg; float C;
};
template <int DQK, int DV, bool MASKED, bool GATED, bool ROPEQ>
__device__ __forceinline__ void attn_unit(const AttnP& P, int qb, LAS char* lds, int tid_in) {
    int tid = tid_in; asm volatile("" : "+v"(tid));
    constexpr int ND0 = DQK / 16, NCB = DV / 32, KB_BYTES = DQK * 128, VB_BYTES = 64 * DV * 2, NK = (8 * DQK + 511) / 512, NV = (8 * DV) / 512;
    const int wid = __builtin_amdgcn_readfirstlane(tid >> 6), lane = tid & 63, r32 = lane & 31, hi = lane >> 5;
    LAS char* Vl = lds; LAS char* Kl = lds + 2 * VB_BYTES;
    LAS float* ws = (LAS float*)(lds + 2 * VB_BYTES + 2 * KB_BYTES) + wid * 64; LAS float* li_l = ws; LAS float* al_l = ws + 32;
    LAS bf16* stg = (LAS bf16*)(lds + 2 * VB_BYTES + 2 * KB_BYTES + 2048) + wid * (32 * DV);
    const int q0 = qb * 256;
    const float C = P.C, thr_raw = THR_NAT * 1.4426950408889634f / C;
    float m_reg = -1e30f, l_reg = 0.f; f32x16 o[NCB]; bf16x8 qr[ND0];
#pragma unroll
    for (int d = 0; d < NCB; ++d)
#pragma unroll
        for (int q = 0; q < 16; ++q) o[d][q] = 0.f;
    {
        const bf16* Qw = P.Q + (size_t)(q0 + wid * 32 + r32) * P.ldq + hi * 8;
#pragma unroll
        for (int d0 = 0; d0 < ND0; ++d0) qr[d0] = *(const GAS bf16x8*)(Qw + d0 * 16);
        if constexpr (ROPEQ) {
            const float* cp = P.cs + (size_t)(q0 + wid * 32 + r32) * 16 + 8 * hi; const float* sp = P.sn + (size_t)(q0 + wid * 32 + r32) * 16 + 8 * hi;
            const f32x4 c0 = *(const GAS f32x4*)cp, c1 = *(const GAS f32x4*)(cp + 4), s0 = *(const GAS f32x4*)sp, s1 = *(const GAS f32x4*)(sp + 4);
            const float co[8] = {c0.x, c0.y, c0.z, c0.w, c1.x, c1.y, c1.z, c1.w}, si[8] = {s0.x, s0.y, s0.z, s0.w, s1.x, s1.y, s1.z, s1.w};
            bf16x8 a = qr[ND0 - 2], bq = qr[ND0 - 1];
#pragma unroll
            for (int j = 0; j < 8; ++j) { const float x1 = bf2f((bf16)a[j]), x2 = bf2f((bf16)bq[j]);
                a[j] = (short)f2bf(x1 * co[j] - x2 * si[j]); bq[j] = (short)f2bf(x1 * si[j] + x2 * co[j]); }
            qr[ND0 - 2] = a; qr[ND0 - 1] = bq;
        }
    }
    unsigned kofg[NK]; int koff[NK]; bool kval[NK];
    { const int row = 8 * (tid >> 6) + (tid & 7), c = (tid & 63) >> 3; kofg[0] = (unsigned)(row * P.ldk + c * 8); koff[0] = c * 1024 + row * 16; kval[0] = true; }
    if constexpr (NK == 2) { const int row = 8 * ((tid & 255) >> 5) + (tid & 7), c = (tid & 31) >> 3; kofg[1] = (unsigned)(row * P.ldk2 + c * 8); koff[1] = (8 + c) * 1024 + row * 16; kval[1] = tid < 256; }
    unsigned vofg[NV]; int voff[NV];
#pragma unroll
    for (int i = 0; i < NV; ++i) { const int p = tid + 512 * i, row = p / (DV / 8), c8 = (p % (DV / 8)) * 8; voff[i] = v_st<NCB>(row, c8); vofg[i] = (unsigned)(row * P.ldv + c8); }
    const int vb0 = (int)(unsigned)(uintptr_t)Vl + v_rd_base(lane);
    const unsigned* mrow = MASKED ? P.mask + (size_t)(q0 + wid * 32 + r32) * 256 : nullptr;
    bf16x8 ksr[NK], vsr[NV]; u32x2 mw = {0u, 0u}, mwn = {0u, 0u};
#define SLOAD(k0) do { { const bf16* kb_u = P.K + (size_t)(k0) * P.ldk; ksr[0] = *(const GAS bf16x8*)(kb_u + kofg[0]); } \
    if constexpr (NK == 2) { const bf16* kb2_u = P.K2 + (size_t)(k0) * P.ldk2; if (kval[1]) ksr[1] = *(const GAS bf16x8*)(kb2_u + kofg[1]); } \
    { const bf16* vb_u = P.V + (size_t)(k0) * P.ldv; _Pragma("unroll") for (int i_ = 0; i_ < NV; ++i_) vsr[i_] = *(const GAS bf16x8*)(vb_u + vofg[i_]); } \
    if (MASKED) { DBG_MWLOAD(k0); } } while (0)
#define SWRITE(b) do { _Pragma("unroll") for (int i_ = 0; i_ < NK; ++i_) if (kval[i_]) *(LAS bf16x8*)(Kl + (b) * KB_BYTES + koff[i_]) = ksr[i_]; \
    _Pragma("unroll") for (int i_ = 0; i_ < NV; ++i_) *(LAS bf16x8*)(Vl + (b) * VB_BYTES + voff[i_]) = vsr[i_]; mw = mwn; } while (0)
#define SWAIT() asm volatile("s_waitcnt vmcnt(0)" ::: "memory")
#define RESC(a) do { if (__any((a) < 1.f)) { if (hi == 0) al_l[r32] = (a); asm volatile("s_waitcnt lgkmcnt(0)" ::: "memory"); \
    _Pragma("unroll") for (int d_ = 0; d_ < NCB; ++d_) _Pragma("unroll") for (int r_ = 0; r_ < 16; ++r_) o[d_][r_] *= al_l[crow(r_, hi)]; } } while (0)
    const int NT = (q0 + 256) / 64, qrel = wid * 32 + r32;
#define DBG_MWLOAD(k0) mwn = *(const GAS u32x2*)(mrow + ((k0) >> 5))
#define MASKT(P0, P1, t) do { if (!MASKED) { const int jb_ = (t) - (NT - 4); if (jb_ >= 0) cmask(P0, P1, jb_, qrel, hi); } } while (0)
    f32x16 pA0, pA1, pB0, pB1; float mnA, mnB, alA, alB; bf16x8 pa0, pa1, pa2, pa3;
    SLOAD(0); SWAIT(); SWRITE(0); __syncthreads();
    qkt<ND0, MASKED>(pA0, pA1, Kl, qr, r32, hi, mw); MASKT(pA0, pA1, 0); partialSM(pA0, pA1, m_reg, mnA, alA, C, thr_raw);
    SLOAD(64); SWAIT(); SWRITE(1); __syncthreads();
    for (int j = 1; j + 1 < NT; j += 2) {
        SBAR(); qkt<ND0, MASKED>(pB0, pB1, Kl + KB_BYTES, qr, r32, hi, mw); MASKT(pB0, pB1, j);
        finishSM(pA0, pA1, alA, l_reg, pa0, pa1, pa2, pa3); SBAR();
        SLOAD((j + 1) * 64); SBAR();
        pv_all<NCB>(o, vb0, pa0, pa1, pa2, pa3); partialSM(pB0, pB1, m_reg, mnB, alB, C, thr_raw);
        __syncthreads(); SWAIT(); SWRITE(0);
        RESC(alB); __syncthreads();
        SBAR(); qkt<ND0, MASKED>(pA0, pA1, Kl, qr, r32, hi, mw); MASKT(pA0, pA1, j + 1);
        finishSM(pB0, pB1, alB, l_reg, pa0, pa1, pa2, pa3); SBAR();
        SLOAD((j + 2) * 64); SBAR();
        pv_all<NCB>(o, vb0 + VB_BYTES, pa0, pa1, pa2, pa3); partialSM(pA0, pA1, m_reg, mnA, alA, C, thr_raw);
        __syncthreads(); SWAIT(); SWRITE(1);
        RESC(alA); __syncthreads();
    }
    SBAR(); qkt<ND0, MASKED>(pB0, pB1, Kl + KB_BYTES, qr, r32, hi, mw); MASKT(pB0, pB1, NT - 1);
    finishSM(pA0, pA1, alA, l_reg, pa0, pa1, pa2, pa3); SBAR();
    pv_all<NCB>(o, vb0, pa0, pa1, pa2, pa3); partialSM(pB0, pB1, m_reg, mnB, alB, C, thr_raw);
    RESC(alB);
    finishSM(pB0, pB1, alB, l_reg, pa0, pa1, pa2, pa3); SBAR();
    pv_all<NCB>(o, vb0 + VB_BYTES, pa0, pa1, pa2, pa3);
    int lane_e = lane; asm volatile("" : "+v"(lane_e));
    const int r32e = lane_e & 31, hie = lane_e >> 5;
    if (hie == 0) li_l[r32e] = l_reg;
    asm volatile("s_waitcnt lgkmcnt(0)" ::: "memory");
    const size_t orow0 = (size_t)(q0 + wid * 32);
    LAS bf16* stg_e = stg + r32e;
    const bf16* gp = GATED ? P.G + orow0 * P.ldg : nullptr;
#pragma unroll
    for (int r = 0; r < 16; ++r) { const int orow = crow(r, hie); const float rl = __builtin_amdgcn_rcpf(li_l[orow]);
#pragma unroll
        for (int d0 = 0; d0 < NCB; ++d0) { float v = o[d0][r] * rl;
            if constexpr (GATED) { const float gte = bf2f(gp[(unsigned)(orow * P.ldg + d0 * 32 + r32e)]); v *= silu(gte); }
            stg_e[orow * DV + d0 * 32] = (bf16)f2bf(v); } }
    asm volatile("s_waitcnt lgkmcnt(0)" ::: "memory");
    constexpr int CPR = DV / 8, RPI = 64 / CPR;
    bf16* op = P.O + orow0 * P.ldo;
#pragma unroll
    for (int i = 0; i < 32 / RPI; ++i) { const int row = i * RPI + lane_e / CPR, ch = lane_e % CPR;
        const v4u v = *(const LAS v4u*)(stg + row * DV + ch * 8); *(GAS v4u*)(op + (unsigned)(row * P.ldo + ch * 8)) = v; }
    __syncthreads();
#undef SLOAD
#undef SWRITE
#undef SWAIT
#undef RESC
#undef MASKT
}
#undef SBAR
}

__device__ __forceinline__ void mla_prep_rows(Frame& F) {
    const int gw = F.vcu * NWAVES + F.wave, NGW = F.G * NWAVES, lane = F.lane;
    const bf16* P = (const bf16*)(F.ws + WS_B);
    bf16* cqn = (bf16*)(F.ws + WS_MASK); bf16* ckvn = (bf16*)(F.ws + WS_MASK + 8 * MiB); bf16* krope = (bf16*)(F.ws + WS_KROPE);
    const float* cosD = (const float*)(F.ws + WS_ROPE) + (size_t)M * 64; const float* sinD = cosD + (size_t)M * 16;
    for (int t = gw; t < M; t += NGW) {
        const bf16* pr = P + (size_t)t * N1;
        { const u32x2 w = *(const GAS u32x2*)(pr + C1_DCQ + 4 * lane); const float a = bflo(w.x), b = bfhi(w.x), c = bflo(w.y), d = bfhi(w.y);
          const float r = 1.0f / sqrtf(wave_sum(a * a + b * b + c * c + d * d) * (1.f / 256.f) + NORM_EPS);
          const f32x4 g = *(const GAS f32x4*)(F.q_norm + 4 * lane);
          *(GAS u32x2*)(cqn + (size_t)t * 256 + 4 * lane) = (u32x2){pk2(a * r * g.x, b * r * g.y), pk2(c * r * g.z, d * r * g.w)}; }
        { const unsigned w = *(const GAS unsigned*)(pr + C1_DCKV + 2 * lane); const float a = bflo(w), b = bfhi(w);
          const float r = 1.0f / sqrtf(wave_sum(a * a + b * b) * (1.f / 128.f) + NORM_EPS);
          *(GAS unsigned*)(ckvn + (size_t)t * 128 + 2 * lane) = pk2(a * r * F.kv_norm[2 * lane], b * r * F.kv_norm[2 * lane + 1]); }
        if (lane < 16) { const float x1 = bf2f(pr[C1_DKR + lane]), x2 = bf2f(pr[C1_DKR + 16 + lane]); const float c = cosD[(size_t)t * 16 + lane], s = sinD[(size_t)t * 16 + lane];
          krope[(size_t)t * 32 + lane] = (bf16)f2bf(x1 * c - x2 * s); krope[(size_t)t * 32 + 16 + lane] = (bf16)f2bf(x1 * s + x2 * c); }
    }
}
__device__ __forceinline__ void diff_finalize_rows(Frame& F) {
    const int gw = F.vcu * NWAVES + F.wave, NGW = F.G * NWAVES, lane = F.lane;
    const bf16* P = (const bf16*)(F.ws + WS_B); const bf16* oC = (const bf16*)(F.ws + WS_MASK); bf16* MIX = (bf16*)(F.ws + WS_A);
    const float lam_init = 0.8f - 0.6f * 0.74081822068171786607f;
    const float d1 = wave_sum(F.diff_lambda[lane] * F.diff_lambda[64 + lane]), d2 = wave_sum(F.diff_lambda[128 + lane] * F.diff_lambda[192 + lane]);
    const float lam = __expf(d1) - __expf(d2) + lam_init;
    const int h = lane >> 4, e0 = (lane & 15) * 8;
    float sub[8];
#pragma unroll
    for (int j = 0; j < 8; ++j) sub[j] = F.diff_subln[e0 + j] * (1.0f - lam_init);
    for (int t = gw; t < M; t += NGW) {
        const v4u a = *(const GAS v4u*)(oC + (size_t)t * 1024 + h * 128 + e0), b = *(const GAS v4u*)(oC + (size_t)t * 1024 + (4 + h) * 128 + e0);
        const v4u gv = *(const GAS v4u*)(P + (size_t)t * N1 + C1_CG + h * 128 + e0);
        const unsigned aw[4] = {a.x, a.y, a.z, a.w}, bw[4] = {b.x, b.y, b.z, b.w}, gw4[4] = {gv.x, gv.y, gv.z, gv.w};
        float d[8]; float s = 0.f;
#pragma unroll
        for (int j = 0; j < 8; ++j) { const float x = (j & 1) ? bfhi(aw[j >> 1]) : bflo(aw[j >> 1]), y = (j & 1) ? bfhi(bw[j >> 1]) : bflo(bw[j >> 1]); d[j] = x - lam * y; s += d[j] * d[j]; }
        s += __shfl_xor(s, 1); s += __shfl_xor(s, 2); s += __shfl_xor(s, 4); s += __shfl_xor(s, 8);
        const float r = 1.0f / sqrtf(s * (1.f / 128.f) + NORM_EPS);
        float o[8];
#pragma unroll
        for (int j = 0; j < 8; ++j) { const float g = (j & 1) ? bfhi(gw4[j >> 1]) : bflo(gw4[j >> 1]); o[j] = d[j] * r * sub[j] * silu(g); }
        *(GAS v4u*)(MIX + (size_t)t * DM + h * 128 + e0) = (v4u){pk2(o[0], o[1]), pk2(o[2], o[3]), pk2(o[4], o[5]), pk2(o[6], o[7])};
    }
}

constexpr int N_PHASES = 14;
struct Args { const void* in[14]; float* out; unsigned char* ws; int ph_lo, ph_hi; };
__global__ void __launch_bounds__(NWAVES * 64, 2) fwd_kernel(Args args) {
    extern __shared__ __attribute__((aligned(16))) unsigned char lds[];
    Frame F;
    F.lds = (LAS unsigned char*)lds;
    F.MISC = (volatile LAS unsigned*)(F.lds + MISC_OFF);
    F.tid = threadIdx.x; F.lane = F.tid & 63; F.wave = __builtin_amdgcn_readfirstlane(F.tid >> 6);
    F.G = gridDim.x; { const int bx = blockIdx.x; F.vcu = (F.G % 8 == 0) ? (bx % 8) * (F.G / 8) + bx / 8 : bx; }
    F.ws = args.ws; F.ctl = (gu32*)(args.ws + WS_CTL);
    F.x = (const float*)args.in[0]; F.pos = (const int*)args.in[1]; F.pre_norm = (const float*)args.in[2]; F.post_norm = (const float*)args.in[3];
    F.w_in_even = (const float*)args.in[4]; F.w_out_even = (const float*)args.in[5]; F.w_in_odd = (const float*)args.in[6]; F.diff_lambda = (const float*)args.in[7];
    F.diff_subln = (const float*)args.in[8]; F.q_norm = (const float*)args.in[9]; F.kv_norm = (const float*)args.in[10]; F.w_uq = (const float*)args.in[11];
    F.w_ukv = (const float*)args.in[12]; F.w_out_odd = (const float*)args.in[13]; F.out = args.out;
    for (int u = F.tid; u < (LDS_BYTES - LDSCTL_OFF) / 4; u += NWAVES * 64) ((LAS unsigned*)(F.lds + LDSCTL_OFF))[u] = 0u;
    __syncthreads();
    XcdBarrier bar; bar.bar = (unsigned*)(F.ctl + CW_BAR); bar.x = 0; bar.st = nullptr;
    if (MK_N_LAUNCHES == 1) bar = xcd_barrier_post((unsigned*)(F.ctl + CW_BAR), F.MISC + 8);
    const int lo = args.ph_lo, hi = args.ph_hi;
#ifdef ONLY_PHASE
#define IN(k) ((k) == ONLY_PHASE && lo <= (k) && (k) < hi)
#else
#define IN(k) (lo <= (k) && (k) < hi)
#endif
#ifndef PROBE_DUP
#define PROBE_DUP 0
#endif
#define REP(k)
#define SEAM(k) do { if (MK_N_LAUNCHES == 1 && IN(k) && IN((k) + 1)) xcd_barrier(bar); } while (0)
    bf16* const HA = (bf16*)(F.ws + WS_A);
    bf16* const PB = (bf16*)(F.ws + WS_B);
    float* const MB = (float*)(F.ws + WS_B);
    LAS char* const alds = (LAS char*)(F.lds + RING_OFF);

    if (IN(0)) { p0_prologue(F); }
    SEAM(0);
#if MK_STAGE == 1
    if (IN(1)) { const int gt = F.vcu * (NWAVES * 64) + F.tid, NGT = F.G * NWAVES * 64; for (size_t e = gt; e < (size_t)M * DM / 4; e += NGT) ((f32x4*)F.out)[e] = ((const f32x4*)F.x)[e]; }
#else
    if (IN(1)) REP(1) { __syncthreads(); pg8::Gemm g{HA, (const bf16*)(F.ws + WS_W0T), M, N0, DM}; pg8::StaticOrder S; S.init(M, N0, F.G, (int)blockIdx.x);
        pg8::EpiBf16<0> E{PB, N0, nullptr, 0, 0, 1.f};
        pg8::gemm_phase<pg8::EpiBf16<0>, pg8::StaticOrder, true, true>(F.lds + RING_OFF, g, S, E); }
    SEAM(1);
    if (IN(2)) REP(2) { __syncthreads();
        for (int it = F.vcu; it < 512; it += F.G) ret_u_item(F, it);
        for (int c = F.vcu; c < 256; c += F.G) { const int b = c >> 7, gi = c & 127;
#pragma unroll 1
            for (int k = 0; k < 2; ++k) idx_item(F, b, k ? gi : 255 - gi); }
    }
    SEAM(2);
    if (IN(3)) { ret_scan(F); }
    SEAM(3);
    if (IN(4)) REP(4) { __syncthreads();
#if defined(DBG_NO_A) || defined(DBG_NO_RET)
        { const int gt = F.vcu * (NWAVES * 64) + F.tid, NGT = F.G * NWAVES * 64;
          for (size_t e = gt; e < (size_t)M * 64; e += NGT) { const size_t row = e >> 6, c8 = (e & 63) * 8;
#ifdef DBG_NO_A
              *(v4u*)(HA + row * DM + c8) = (v4u){0u, 0u, 0u, 0u};
#endif
#ifdef DBG_NO_RET
              *(v4u*)(HA + row * DM + 512 + c8) = (v4u){0u, 0u, 0u, 0u};
#endif
          } }
#endif
#ifndef DBG_NO_A
        for (int pu = F.vcu; pu < 256; pu += F.G) {
            const int bh = pu >> 4, s = pu & 15, b = bh >> 3, h = bh & 7;
            att::AttnP A;
            const bf16* Pb = PB + (size_t)b * T * N0;
            A.Q = Pb + C0_AQ + h * 64; A.K = Pb + C0_AK + h * 64; A.K2 = nullptr; A.V = Pb + C0_AV + h * 64; A.G = Pb + C0_AG + h * 64;
            A.O = HA + (size_t)b * T * DM + h * 64; A.mask = (const unsigned*)(F.ws + WS_MASK) + (size_t)b * T * 256; A.cs = nullptr; A.sn = nullptr;
            A.ldq = N0; A.ldk = N0; A.ldk2 = 0; A.ldv = N0; A.ldo = DM; A.ldg = N0; A.C = 0.125f * 1.4426950408889634f;
#pragma unroll 1
            for (int k = 0; k < 2; ++k) att::attn_unit<64, 64, true, true, false>(A, k ? s : 31 - s, alds, F.tid);
        }
#endif
#ifndef DBG_NO_RET
        for (int it = F.vcu; it < 512; it += F.G) ret_out_item(F, it);
#endif
    }
    SEAM(4);
    if (IN(5)) REP(5) { __syncthreads(); pg8::Gemm g{HA, (const bf16*)(F.ws + WS_WO0T), M, DM, DM}; pg8::StaticOrder S; S.init(M, DM, F.G, (int)blockIdx.x);
        EpiF32 E{MB, DM};
        pg8::gemm_phase<EpiF32, pg8::StaticOrder, false, true>(F.lds + RING_OFF, g, S, E); }
    SEAM(5);
    if (IN(6)) REP(6) { __syncthreads(); post_norm_rows<true>(F, F.x, MB, F.post_norm, F.pre_norm + DM, F.out, HA); }
    SEAM(6);
#if MK_STAGE >= 3
    if (IN(7)) REP(7) { __syncthreads(); pg8::Gemm g{HA, (const bf16*)(F.ws + WS_W1T), M, N1, DM}; pg8::StaticOrder S; S.init(M, N1, F.G, (int)blockIdx.x);
        pg8::EpiBf16<0> E{PB, N1, nullptr, 0, 0, 1.f};
        pg8::gemm_phase<pg8::EpiBf16<0>, pg8::StaticOrder, true, true>(F.lds + RING_OFF, g, S, E); }
    SEAM(7);
    if (IN(8)) REP(8) { __syncthreads(); mla_prep_rows(F); }
    SEAM(8);
    if (IN(9)) REP(9) { __syncthreads();
        { pg8::Gemm g{(const bf16*)(F.ws + WS_MASK), (const bf16*)(F.ws + WS_WUQT), M, 768, 256}; pg8::StaticOrder S; S.init(M, 768, F.G, (int)blockIdx.x);
          pg8::EpiBf16<0> E{(bf16*)(F.ws + WS_QD), 768, nullptr, 0, 0, 1.f};
          pg8::gemm_phase<pg8::EpiBf16<0>, pg8::StaticOrder, true, true>(F.lds + RING_OFF, g, S, E); }
        __syncthreads();
        { pg8::Gemm g{(const bf16*)(F.ws + WS_MASK + 8 * MiB), (const bf16*)(F.ws + WS_WUKVT), M, 1024, 128}; pg8::StaticOrder S; S.init(M, 1024, F.G, (int)blockIdx.x);
          pg8::EpiBf16<0> E{(bf16*)(F.ws + WS_KVX), 1024, nullptr, 0, 0, 1.f};
          pg8::gemm_phase<pg8::EpiBf16<0>, pg8::StaticOrder, true, true>(F.lds + RING_OFF, g, S, E); }
    }
    SEAM(9);
    if (IN(10)) REP(10) { __syncthreads();
        for (int pu = F.vcu; pu < 256; pu += F.G) {
            const int bh = pu >> 4, s = pu & 15, b = bh >> 3, hs = bh & 7;
#ifndef PH10_NO_C
            {   att::AttnP A; const bf16* Pb = PB + (size_t)b * T * N1; const int h = hs & 3, mp = hs >> 2;
                A.Q = Pb + C1_CQ + h * 128 + 64 * mp; A.K = Pb + C1_CK + h * 128 + 64 * mp; A.K2 = nullptr; A.V = Pb + C1_CV + h * 128; A.G = nullptr;
                A.O = (bf16*)(F.ws + WS_MASK) + (size_t)b * T * 1024 + hs * 128; A.mask = nullptr; A.cs = nullptr; A.sn = nullptr;
                A.ldq = N1; A.ldk = N1; A.ldk2 = 0; A.ldv = N1; A.ldo = 1024; A.ldg = 0; A.C = 0.125f * 1.4426950408889634f;
#pragma unroll 1
                for (int k = 0; k < 2; ++k) att::attn_unit<64, 128, false, false, false>(A, k ? s : 31 - s, alds, F.tid); }
#endif
#ifndef PH10_NO_D
            {   att::AttnP A; const int h = hs;
                A.Q = (const bf16*)(F.ws + WS_QD) + (size_t)b * T * 768 + h * 96; A.K = (const bf16*)(F.ws + WS_KVX) + (size_t)b * T * 1024 + h * 128;
                A.K2 = (const bf16*)(F.ws + WS_KROPE) + (size_t)b * T * 32; A.V = (const bf16*)(F.ws + WS_KVX) + (size_t)b * T * 1024 + h * 128 + 64;
                A.G = PB + (size_t)b * T * N1 + C1_DG + h * 64; A.O = HA + (size_t)b * T * DM + 512 + h * 64; A.mask = nullptr;
                A.cs = (const float*)(F.ws + WS_ROPE) + (size_t)M * 64 + (size_t)b * T * 16; A.sn = A.cs + (size_t)M * 16;
                A.ldq = 768; A.ldk = 1024; A.ldk2 = 32; A.ldv = 1024; A.ldo = DM; A.ldg = N1; A.C = 0.10206207261596575f * 1.4426950408889634f;
#pragma unroll 1
                for (int k = 0; k < 2; ++k) att::attn_unit<96, 64, false, true, true>(A, k ? s : 31 - s, alds, F.tid); }
#endif
        }
    }
    SEAM(10);
    if (IN(11)) REP(11) { __syncthreads(); diff_finalize_rows(F); }
    SEAM(11);
    if (IN(12)) REP(12) { __syncthreads(); pg8::Gemm g{HA, (const bf16*)(F.ws + WS_WO1T), M, DM, DM}; pg8::StaticOrder S; S.init(M, DM, F.G, (int)blockIdx.x);
        EpiF32 E{MB, DM};
        pg8::gemm_phase<EpiF32, pg8::StaticOrder, false, true>(F.lds + RING_OFF, g, S, E); }
    SEAM(12);
    if (IN(13)) { post_norm_rows<false>(F, F.out, MB, F.post_norm + DM, nullptr, F.out, nullptr); }
#endif
#endif
#undef IN
#undef SEAM
}

extern "C" void kernel_launch(void* const* d_in, const int* in_sizes, int n_in, void* d_out, int out_size, void* d_ws, size_t ws_size, hipStream_t stream) {
    static int grid = 0;
    if (grid == 0) {
        if (n_in != 14 || in_sizes[0] != M * DM || out_size != M * DM || ws_size < WS_END) { fprintf(stderr, "kernel_launch: unexpected shapes (n_in %d, in0 %d, out %d, ws %zu); nothing launched\n", n_in, n_in > 0 ? in_sizes[0] : -1, out_size, ws_size); grid = -1; return; }
        int dev = 0, cus = 0, per_cu = 0;
        if (hipGetDevice(&dev) != hipSuccess || hipDeviceGetAttribute(&cus, hipDeviceAttributeMultiprocessorCount, dev) != hipSuccess) { grid = -1; return; }
        if (hipFuncSetAttribute((const void*)fwd_kernel, hipFuncAttributeMaxDynamicSharedMemorySize, LDS_BYTES) != hipSuccess) { fprintf(stderr, "kernel_launch: hipFuncSetAttribute failed\n"); grid = -1; return; }
        if (hipOccupancyMaxActiveBlocksPerMultiprocessor(&per_cu, (const void*)fwd_kernel, NWAVES * 64, LDS_BYTES) != hipSuccess || per_cu < 1)
            fprintf(stderr, "kernel_launch: note: occupancy query reports %d workgroups per CU\n", per_cu);
        (void)hipGetLastError();
        grid = cus;
    }
    if (grid < 0) return;
    if (hipMemsetAsync((char*)d_ws + WS_CTL, 0, CTL_ZERO_BYTES, stream) != hipSuccess) { fprintf(stderr, "kernel_launch: hipMemsetAsync failed\n"); return; }
    Args a{};
    for (int i = 0; i < 14; ++i) a.in[i] = d_in[i];
    a.out = (float*)d_out; a.ws = (unsigned char*)d_ws;
#if MK_N_LAUNCHES == 1
    a.ph_lo = 0; a.ph_hi = N_PHASES;
    hipLaunchKernelGGL(fwd_kernel, dim3(grid), dim3(NWAVES * 64), LDS_BYTES, stream, a);
#else
    for (int p = 0; p < N_PHASES; ++p) { a.ph_lo = p; a.ph_hi = p + 1; const int reps = ((PROBE_DUP >> p) & 1) ? 2 : 1;
        for (int r = 0; r < reps; ++r) hipLaunchKernelGGL(fwd_kernel, dim3(grid), dim3(NWAVES * 64), LDS_BYTES, stream, a); }
#endif
    const hipError_t le = hipPeekAtLastError();
    if (le != hipSuccess) fprintf(stderr, "kernel_launch: launch failed: %s\n", hipGetErrorName(le));
}
```

```cpp
#include <hip/hip_runtime.h>
#include <cstdio>
#include <cstdint>
#ifndef MK_STAGE
#define MK_STAGE 3
#endif
#ifndef PROBE_DUP
#define PROBE_DUP 0x0
#endif
#ifndef MK_N_LAUNCHES
#define MK_N_LAUNCHES 1
#endif
namespace pg8 {
#define PG8_LAS __attribute__((address_space(3)))
typedef unsigned short bf16_t;
typedef short bf16x8 __attribute__((ext_vector_type(8)));
typedef float f32x4 __attribute__((ext_vector_type(4)));
typedef unsigned u32x4 __attribute__((ext_vector_type(4)));
constexpr int BM = 256, BK = 64, HALF = 128, HTB = HALF * BK * 2  , STAGE_BYTES = 8 * HTB, NXCD = 8, WGM = 8;

__host__ __device__ __forceinline__ int lds_byte(int r, int c) { const int st = (r >> 4) * 2 + (c >> 5), rr = r & 15, cc = c & 31, ob = rr * 64 + cc * 2; return st * 1024 + (ob ^ (((ob >> 9) & 1) << 5)); }
__host__ __device__ __forceinline__ void stage_rc(int b, int& R, int& C) { const int st = b / 1024, sb = b % 1024, swz = sb ^ (((sb >> 9) & 1) << 5); R = (st >> 1) * 16 + swz / 64; C = (st & 1) * 32 + (swz % 64) / 2; }
__host__ __device__ __forceinline__ int perm32(int rho) { const int n = rho >> 4, i = rho & 15; return 8 * (i >> 2) + 4 * n + (i & 3); }

struct Unit { int pm, pn; };
struct Gemm { const bf16_t* A; const bf16_t* Bt; int M, N, K; };

struct StaticOrder {
    int nM, nN, nwg, G, c;
    __host__ __device__ void init(int M, int N, int G_, int c_) { nM = M / BM; nN = N / BM; nwg = nM * nN; G = G_; c = c_; }
    __host__ __device__ bool next(int i, Unit& u) const {
        const long L = (long)i * G + c; if (L >= nwg) return false;
        int wgid = (int)L; { const int q = nwg / NXCD, r = nwg % NXCD, xcd = wgid % NXCD, off = wgid / NXCD; wgid = (xcd < r ? xcd * (q + 1) : r * (q + 1) + (xcd - r) * q) + off; }
        const int nig = WGM * nN, gid = wgid / nig, fm = gid * WGM, gsz = (nM - fm) < WGM ? (nM - fm) : WGM;
        u.pm = fm + ((wgid % nig) % gsz); u.pn = (wgid % nig) / gsz; return true;
    }
    __device__ __forceinline__ void a_ready(const Unit&) const {}
    __device__ __forceinline__ void done(const Unit&) const {}
};

__device__ __forceinline__ unsigned cvt_pk_bf16(float lo, float hi) { unsigned r; asm volatile("v_cvt_pk_bf16_f32 %0, %1, %2" : "=v"(r) : "v"(lo), "v"(hi)); return r; }
typedef float f32x2 __attribute__((ext_vector_type(2)));
__device__ __forceinline__ f32x2 gelu_pk(f32x2 v) {
    const f32x2 av = __builtin_elementwise_abs(v), d = av * 0.2316418882f + 1.0f;
    f32x2 t; t.x = __builtin_amdgcn_rcpf(d.x); t.y = __builtin_amdgcn_rcpf(d.y);
    f32x2 q = t * 0.5307027145f + (-0.7265760135f); q = q * t + 0.7107068705f; q = q * t + (-0.142248368f); q = q * t + 0.127414796f; q = q * t;
    const f32x2 s = (v * v) * (-0.72134752044f);
    f32x2 e; e.x = __builtin_amdgcn_exp2f(s.x); e.y = __builtin_amdgcn_exp2f(s.y);
    const f32x2 m = v * (q * e), r = v - m;
    f32x2 o; o.x = v.x < 0.f ? m.x : r.x; o.y = v.y < 0.f ? m.y : r.y; return o;
}

template <int ACT  > struct EpiBf16 {
    static constexpr bool PERM = true, AFTER_DRAIN = false; static_assert(ACT == 0 || ACT == 1, "EpiBf16: ACT is 0 (none) or 1 (gelu_pk)");
    bf16_t* O; int ldc; const float* bias; int split_cols; size_t split_stride; float scale0;
    __device__ __forceinline__ void operator()(const f32x4 (&acc)[2][2][4][2], const Unit& u, int wr, int wc, int fr, int fq) const {
        const int row0 = u.pm * BM + wr * 64 + fr; int colt = u.pn * BM; bf16_t* base = O;
        float sc = 1.f; if (split_cols) { const int t = colt / split_cols; base += (size_t)t * split_stride; colt -= t * split_cols; if (t == 0) sc = scale0; }
        const int col0 = colt + wc * 32 + 8 * fq, bcol0 = u.pn * BM + wc * 32 + 8 * fq;
        f32x4 bv[2][2];
#pragma unroll
        for (int bj = 0; bj < 2; ++bj)
#pragma unroll
            for (int n = 0; n < 2; ++n) bv[bj][n] = bias ? *(const f32x4*)(bias + bcol0 + bj * HALF + 4 * n) : (f32x4){0.f, 0.f, 0.f, 0.f};
#pragma unroll
        for (int ai = 0; ai < 2; ++ai)
#pragma unroll
            for (int m = 0; m < 4; ++m) { bf16_t* rowp = base + (size_t)(row0 + ai * HALF + m * 16) * ldc + col0;
#pragma unroll
                for (int bj = 0; bj < 2; ++bj) { f32x4 v0 = acc[ai][bj][m][0] + bv[bj][0], v1 = acc[ai][bj][m][1] + bv[bj][1];
                    if (ACT == 1) { f32x2 a = gelu_pk((f32x2){v0[0], v0[1]}), b = gelu_pk((f32x2){v0[2], v0[3]}), c = gelu_pk((f32x2){v1[0], v1[1]}), d = gelu_pk((f32x2){v1[2], v1[3]});
                        v0 = (f32x4){a.x, a.y, b.x, b.y}; v1 = (f32x4){c.x, c.y, d.x, d.y}; }
                    v0 = v0 * sc; v1 = v1 * sc; u32x4 w; w.x = cvt_pk_bf16(v0[0], v0[1]); w.y = cvt_pk_bf16(v0[2], v0[3]); w.z = cvt_pk_bf16(v1[0], v1[1]); w.w = cvt_pk_bf16(v1[2], v1[3]);
                    *(u32x4*)(rowp + bj * HALF) = w; } }
    }
};

template <class Epi, class Sched, bool ALIGN_EPI = false, bool SP2 = false>
__device__ __forceinline__ void gemm_phase(PG8_LAS unsigned char* lds, const Gemm g, const Sched& S, const Epi& E) {
    const int tid = threadIdx.x, wid = __builtin_amdgcn_readfirstlane(tid >> 6), lane = tid & 63, wr = wid >> 2, wc = wid & 3, fr = lane & 15, fq = lane >> 4;
    const int K = g.K, nt = K / BK;
    unsigned voffA[2], voffB[2];
#pragma unroll
    for (int i = 0; i < 2; ++i) { int R, C; stage_rc(tid * 16 + i * 8192, R, C); const int Rb = Epi::PERM ? ((R & ~31) + perm32(R & 31)) : R;
        voffA[i] = (unsigned)(R * K + C) * 2u; voffB[i] = (unsigned)(Rb * K + C) * 2u; }
    const size_t kstep = (size_t)(BK * 2);
    const size_t hstep = (size_t)HALF * K * 2;
    const size_t tstep = 2 * hstep;
    const unsigned ldsw = (unsigned)wid * 1024u;
    const int aoff = lds_byte(wr * 64 + fr, fq * 8), boff = lds_byte(wc * 32 + fr, fq * 8);
#define PG8_SA(b, h) (((b) * 2 + (h)) * HTB)
#define PG8_SB(b, h) ((4 + (b) * 2 + (h)) * HTB)
#define PG8_STAGE(bufoff, gbase, voff) do { _Pragma("unroll") for (int _i = 0; _i < 2; ++_i) \
        __builtin_amdgcn_global_load_lds((const unsigned*)((const char*)(gbase) + (voff)[_i]), (PG8_LAS unsigned*)(lds + (bufoff) + ldsw + _i * 8192), 16, 0, 0); } while (0)
#define PG8_LDA(dst, b, h) do { _Pragma("unroll") for (int m = 0; m < 4; ++m) _Pragma("unroll") for (int k = 0; k < 2; ++k) dst[m][k] = *(const PG8_LAS bf16x8*)(lds + PG8_SA(b, h) + aoff + m * 2048 + k * 1024); } while (0)
#define PG8_LDB(dst, b, h) do { _Pragma("unroll") for (int n = 0; n < 2; ++n) _Pragma("unroll") for (int k = 0; k < 2; ++k) dst[n][k] = *(const PG8_LAS bf16x8*)(lds + PG8_SB(b, h) + boff + n * 2048 + k * 1024); } while (0)
#define PG8_MMA(ai, bj, At, Bt) do { __builtin_amdgcn_s_setprio(1); _Pragma("unroll") for (int m = 0; m < 4; ++m) _Pragma("unroll") for (int n = 0; n < 2; ++n) _Pragma("unroll") for (int k = 0; k < 2; ++k) \
        acc[ai][bj][m][n] = __builtin_amdgcn_mfma_f32_16x16x32_bf16(Bt[n][k], At[m][k], acc[ai][bj][m][n], 0, 0, 0); __builtin_amdgcn_s_setprio(0); } while (0)
#define PG8_WAIT_V(n) asm volatile("s_waitcnt vmcnt(" #n ")" ::: "memory")
#define PG8_WAIT_L(n) asm volatile("s_waitcnt lgkmcnt(" #n ")" ::: "memory")
#define PG8_BAR __builtin_amdgcn_s_barrier()
#define PG8_SCHED __builtin_amdgcn_sched_barrier(0)
    Unit cur, nxt; int ui = 0;
    if (!S.next(0, cur)) return;
    f32x4 acc[2][2][4][2];
#pragma unroll
    for (int a = 0; a < 2; ++a)
#pragma unroll
        for (int b = 0; b < 2; ++b)
#pragma unroll
            for (int m = 0; m < 4; ++m)
#pragma unroll
                for (int n = 0; n < 2; ++n) acc[a][b][m][n] = (f32x4){0.f, 0.f, 0.f, 0.f};
    bf16x8 At[4][2], B0[2][2], B1[2][2];
    const char* cA = (const char*)g.A + (size_t)cur.pm * tstep; const char* cB = (const char*)g.Bt + (size_t)cur.pn * tstep;
    S.a_ready(cur);
    if constexpr (SP2) {
        PG8_STAGE(PG8_SB(0, 0), cB, voffB); PG8_STAGE(PG8_SB(0, 1), cB + hstep, voffB); PG8_STAGE(PG8_SA(0, 0), cA, voffA); PG8_STAGE(PG8_SA(0, 1), cA + hstep, voffA);
        if (wr == 1) PG8_BAR;
        PG8_WAIT_V(2); PG8_BAR;
        PG8_STAGE(PG8_SB(1, 0), cB + kstep, voffB); PG8_STAGE(PG8_SA(1, 0), cA + kstep, voffA); PG8_STAGE(PG8_SB(1, 1), cB + hstep + kstep, voffB);
        PG8_WAIT_V(6); PG8_BAR;
    } else {
        PG8_STAGE(PG8_SB(0, 0), cB, voffB); PG8_STAGE(PG8_SA(0, 0), cA, voffA); PG8_STAGE(PG8_SB(0, 1), cB + hstep, voffB); PG8_STAGE(PG8_SA(0, 1), cA + hstep, voffA);
        if (wr == 1) PG8_BAR;
        PG8_WAIT_V(4); PG8_BAR;
        PG8_STAGE(PG8_SB(1, 0), cB + kstep, voffB); PG8_STAGE(PG8_SA(1, 0), cA + kstep, voffA); PG8_STAGE(PG8_SB(1, 1), cB + hstep + kstep, voffB);
        PG8_WAIT_V(6); PG8_BAR;
    }
    for (;;) {
        const bool has_next = S.next(ui + 1, nxt);
        const char* nA = has_next ? (const char*)g.A + (size_t)nxt.pm * tstep : cA; const char* nB = has_next ? (const char*)g.Bt + (size_t)nxt.pn * tstep : cB;
        for (int t = 0; t < nt; t += 2) {
            const bool last = (t == nt - 2);
            const char* a1 = cA + (size_t)(t + 1) * kstep;
            const char* a2 = last ? nA : cA + (size_t)(t + 2) * kstep; const char* b2 = last ? nB : cB + (size_t)(t + 2) * kstep;
            const char* a3 = a2 + kstep; const char* b3 = b2 + kstep;
            if (last && has_next) S.a_ready(nxt);
            if constexpr (SP2) {
            PG8_LDB(B0, 0, 0); PG8_LDB(B1, 0, 1); PG8_SCHED; PG8_LDA(At, 0, 0); PG8_STAGE(PG8_SA(1, 1), a1 + hstep, voffA);
            PG8_WAIT_V(8); PG8_WAIT_L(0); PG8_BAR; PG8_MMA(0, 0, At, B0); PG8_MMA(0, 1, At, B1); PG8_BAR; PG8_SCHED;
            PG8_LDA(At, 0, 1); PG8_STAGE(PG8_SB(0, 0), b2, voffB); PG8_STAGE(PG8_SB(0, 1), b2 + hstep, voffB); PG8_STAGE(PG8_SA(0, 0), a2, voffA);
            PG8_WAIT_V(8); PG8_WAIT_L(0); PG8_BAR; PG8_MMA(1, 0, At, B0); PG8_MMA(1, 1, At, B1); PG8_BAR; PG8_SCHED;
            PG8_LDB(B0, 1, 0); PG8_LDB(B1, 1, 1); PG8_SCHED; PG8_LDA(At, 1, 0); PG8_STAGE(PG8_SA(0, 1), a2 + hstep, voffA);
            PG8_WAIT_V(8); PG8_WAIT_L(0); PG8_BAR; PG8_MMA(0, 0, At, B0); PG8_MMA(0, 1, At, B1); PG8_BAR; PG8_SCHED;
            PG8_LDA(At, 1, 1); PG8_STAGE(PG8_SB(1, 0), b3, voffB); PG8_STAGE(PG8_SB(1, 1), b3 + hstep, voffB); PG8_STAGE(PG8_SA(1, 0), a3, voffA);
            PG8_WAIT_V(8); PG8_WAIT_L(0); PG8_BAR; PG8_MMA(1, 0, At, B0); PG8_MMA(1, 1, At, B1); PG8_BAR; PG8_SCHED;
            } else {
            PG8_LDB(B0, 0, 0); PG8_SCHED; PG8_LDA(At, 0, 0); PG8_STAGE(PG8_SA(1, 1), a1 + hstep, voffA);
            PG8_WAIT_L(8); PG8_BAR; PG8_WAIT_L(0); PG8_MMA(0, 0, At, B0); PG8_BAR; PG8_SCHED;
            PG8_LDB(B1, 0, 1); PG8_STAGE(PG8_SB(0, 0), b2, voffB);
            PG8_BAR; PG8_WAIT_L(0); PG8_MMA(0, 1, At, B1); PG8_BAR;
            PG8_LDA(At, 0, 1); PG8_STAGE(PG8_SA(0, 0), a2, voffA);
            PG8_BAR; PG8_WAIT_L(0); PG8_MMA(1, 0, At, B0); PG8_BAR; PG8_SCHED;
            PG8_STAGE(PG8_SB(0, 1), b2 + hstep, voffB);
            PG8_WAIT_V(6); PG8_BAR; PG8_MMA(1, 1, At, B1); PG8_BAR;
            PG8_LDB(B0, 1, 0); PG8_SCHED; PG8_LDA(At, 1, 0); PG8_STAGE(PG8_SA(0, 1), a2 + hstep, voffA);
            PG8_WAIT_L(8); PG8_BAR; PG8_WAIT_L(0); PG8_MMA(0, 0, At, B0); PG8_BAR; PG8_SCHED;
            PG8_LDB(B1, 1, 1); PG8_STAGE(PG8_SB(1, 0), b3, voffB);
            PG8_BAR; PG8_WAIT_L(0); PG8_MMA(0, 1, At, B1); PG8_BAR;
            PG8_LDA(At, 1, 1); PG8_STAGE(PG8_SA(1, 0), a3, voffA);
            PG8_BAR; PG8_WAIT_L(0); PG8_MMA(1, 0, At, B0); PG8_BAR; PG8_SCHED;
            PG8_STAGE(PG8_SB(1, 1), b3 + hstep, voffB);
            PG8_WAIT_V(6); PG8_BAR; PG8_MMA(1, 1, At, B1); PG8_BAR;
            }
        }
        if constexpr (ALIGN_EPI) { if (wr == 0) PG8_BAR; }
        if constexpr (!Epi::AFTER_DRAIN) { E(acc, cur, wr, wc, fr, fq); S.done(cur); }
        if (!has_next) break;
#pragma unroll
        for (int a = 0; a < 2; ++a)
#pragma unroll
            for (int b = 0; b < 2; ++b)
#pragma unroll
                for (int m = 0; m < 4; ++m)
#pragma unroll
                    for (int n = 0; n < 2; ++n) acc[a][b][m][n] = (f32x4){0.f, 0.f, 0.f, 0.f};
        cur = nxt; cA = nA; cB = nB; ++ui;
        if constexpr (ALIGN_EPI) { if (wr == 1) PG8_BAR; }
    }
    PG8_WAIT_V(0);
    if constexpr (!ALIGN_EPI) { if (wr == 0) PG8_BAR; }
    PG8_BAR;
    if constexpr (Epi::AFTER_DRAIN) { E.fused(acc, cur, wr, wc, fr, fq, lds, wid, lane); S.done(cur); }
#undef PG8_SA
#undef PG8_SB
#undef PG8_STAGE
#undef PG8_LDA
#undef PG8_LDB
#undef PG8_MMA
#undef PG8_WAIT_V
#undef PG8_WAIT_L
#undef PG8_BAR
#undef PG8_SCHED
}
}
#define GAS __attribute__((address_space(1)))
#define LAS __attribute__((address_space(3)))
typedef unsigned short bf16;
typedef unsigned v4u __attribute__((ext_vector_type(4)));
typedef float f32x4 __attribute__((ext_vector_type(4)));
typedef short bf16x8 __attribute__((ext_vector_type(8)));
typedef GAS unsigned gu32;
typedef GAS unsigned long long gu64;
#define RLX_AGENT __ATOMIC_RELAXED, __HIP_MEMORY_SCOPE_AGENT
#define LDS_WAIT() asm volatile("s_waitcnt lgkmcnt(0)" ::: "memory")
#define VM_WAIT() asm volatile("s_waitcnt vmcnt(0)" ::: "memory")
__device__ __forceinline__ unsigned long long rt() { return __builtin_amdgcn_s_memrealtime(); }
__device__ __forceinline__ unsigned f2bf(float f) { unsigned u = __builtin_bit_cast(unsigned, f); return (u + 0x7fffu + ((u >> 16) & 1u)) >> 16; }
__device__ __forceinline__ unsigned pk2(float lo, float hi) { return f2bf(lo) | (f2bf(hi) << 16); }

#define XB_TMO      128
#define XB_XCNT(j)  (256  + 64 * (j))
#define XB_XSUB(j)  (1280 + 64 * (j))
#define XB_XGEN(j)  (2304 + 64 * (j))
#define XB_TOP      3328
#define XB_TOPGEN   3392
#define XCD_BAR_WORDS 3456
#define XB_SPIN_CAP (1u << 20)

__device__ __forceinline__ unsigned xb_ld(unsigned* p)              { return __hip_atomic_load(p, __ATOMIC_RELAXED, __HIP_MEMORY_SCOPE_AGENT); }
__device__ __forceinline__ unsigned xb_add(unsigned* p, unsigned v) { return __hip_atomic_fetch_add(p, v, __ATOMIC_RELAXED, __HIP_MEMORY_SCOPE_AGENT); }
__device__ __forceinline__ unsigned xb_xcc_id() { return (unsigned)__builtin_amdgcn_s_getreg((3 << 11) | 20) & 0xFu; }
#define XB_SPIN(cond, bar) do { unsigned _sp = 0; while (cond) { __builtin_amdgcn_s_sleep(1); \
    if ((++_sp & 255u) == 0u) { if (xb_ld(&(bar)[XB_TMO])) break; if (_sp > XB_SPIN_CAP) { atomicAdd(&(bar)[XB_TMO], 1u); break; } } } } while (0)

struct XcdBarrier {
    unsigned* bar; unsigned x;
    volatile LAS unsigned* st;
};

__device__ __forceinline__ XcdBarrier xcd_barrier_post(unsigned* bar, volatile LAS unsigned* st) {
    XcdBarrier b; b.bar = bar; b.x = xb_xcc_id(); b.st = st;
    if (threadIdx.x == 0) (void)xb_add(&bar[XB_XCNT(b.x)], 1u);
    return b;
}
__device__ __forceinline__ void xcd_barrier_complete(unsigned* bar, unsigned x, unsigned& nloc, unsigned& nx) {
    const unsigned G = gridDim.x * gridDim.y * gridDim.z;
    unsigned sum, cnt, mine, sp = 0u;
    for (;;) {
        sum = 0u; cnt = 0u; mine = 0u;
#pragma unroll
        for (unsigned j = 0; j < 16; ++j) { const unsigned c = xb_ld(&bar[XB_XCNT(j)]); sum += c; cnt += (c > 0u) ? 1u : 0u; mine = (j == x) ? c : mine; }
        if (sum == G) break;
        __builtin_amdgcn_s_sleep(1);
        if ((++sp & 255u) == 0u) { if (xb_ld(&bar[XB_TMO])) break; if (sp > XB_SPIN_CAP) { atomicAdd(&bar[XB_TMO], 1u); break; } }
    }
    nloc = mine > 0u ? mine : 1u; nx = cnt > 0u ? cnt : 1u;
}

__device__ __forceinline__ void xcd_barrier(const XcdBarrier& b) {
    asm volatile("s_waitcnt vmcnt(0)" ::: "memory");
    __syncthreads();
    if (threadIdx.x == 0) {
        unsigned* bar = b.bar;
        __builtin_amdgcn_s_waitcnt(0);
        unsigned nloc = b.st[0], nx = b.st[1];
        if (nloc == 0u) { xcd_barrier_complete(bar, b.x, nloc, nx); b.st[0] = nloc; b.st[1] = nx; }
        const unsigned old = xb_add(&bar[XB_XSUB(b.x)], 1u);
        const unsigned gen = old / nloc;
        if (old + 1u == (gen + 1u) * nloc) {
            __builtin_amdgcn_fence(__ATOMIC_RELEASE, "agent");
            asm volatile("s_waitcnt vmcnt(0)" ::: "memory");
            const unsigned og = xb_add(&bar[XB_TOP], 1u);
            const unsigned tg = og / nx;
            if (og + 1u == (tg + 1u) * nx) xb_add(&bar[XB_TOPGEN], 1u);
            else XB_SPIN(xb_ld(&bar[XB_TOPGEN]) == tg, bar);
            __builtin_amdgcn_fence(__ATOMIC_ACQUIRE, "agent");
            xb_add(&bar[XB_XGEN(b.x)], 1u);
            asm volatile("s_waitcnt vmcnt(0)" ::: "memory");
        } else {
            XB_SPIN(xb_ld(&bar[XB_XGEN(b.x)]) == gen, bar);
            __builtin_amdgcn_fence(__ATOMIC_ACQUIRE, "agent");
            asm volatile("s_waitcnt vmcnt(0)" ::: "memory");
        }
    }
    __syncthreads();
}

constexpr int NWAVES = 8;
constexpr int BATCH = 2, T = 8192, DM = 1024, M = BATCH * T;
constexpr int N0 = 4096, N1 = 3072;
constexpr int EVEN_IN = 3908, ODD_IN = 2976;
constexpr float NORM_EPS = 1e-6f;
constexpr int C0_AQ = 0, C0_AK = 512, C0_AV = 1024, C0_AG = 1536, C0_BQ = 2048, C0_BK = 2304, C0_BV = 2560, C0_BG = 3072, C0_IQ = 3584, C0_IK = 3840, C0_IW = 3904;
constexpr int C1_CQ = 0, C1_CK = 512, C1_CV = 1024, C1_CG = 1536, C1_DCQ = 2048, C1_DCKV = 2304, C1_DKR = 2432, C1_DG = 2464;

constexpr size_t MiB = 1u << 20;
constexpr size_t WS_CTL = 0, CTL_ZERO_BYTES = 1 * MiB;
constexpr size_t WS_W0T = 1 * MiB;
constexpr size_t WS_WO0T = 9 * MiB;
constexpr size_t WS_W1T = 11 * MiB;
constexpr size_t WS_WUQT = 17 * MiB;
constexpr size_t WS_WUKVT = 17 * MiB + 512 * 1024;
constexpr size_t WS_WO1T = 18 * MiB;
constexpr size_t WS_ROPE = 20 * MiB;
constexpr size_t WS_MASK = 26 * MiB;
constexpr size_t WS_U = 42 * MiB;
constexpr size_t WS_A = 58 * MiB;
constexpr size_t WS_B = 90 * MiB;
constexpr size_t WS_QD = 186 * MiB;
constexpr size_t WS_KVX = 218 * MiB;
constexpr size_t WS_KROPE = 250 * MiB;
constexpr size_t WS_END = 256 * MiB;
constexpr int CW_TMO = 0, CW_CODE = 1, CW_BAR = 4096;

constexpr int RING_OFF = 0, RING_BYTES = 131072;
constexpr int LDSCTL_OFF = RING_BYTES, MISC_OFF = LDSCTL_OFF + 320, INFO_OFF = LDSCTL_OFF + 1024;
constexpr int LDS_BYTES = 147456;

typedef float f32x16 __attribute__((ext_vector_type(16)));
typedef short s16x4 __attribute__((ext_vector_type(4)));
typedef unsigned u32x2 __attribute__((ext_vector_type(2)));

__device__ __forceinline__ float bf2f(bf16 b) { return __builtin_bit_cast(float, (unsigned)b << 16); }
__device__ __forceinline__ float bflo(unsigned w) { return __builtin_bit_cast(float, w << 16); }
__device__ __forceinline__ float bfhi(unsigned w) { return __builtin_bit_cast(float, w & 0xffff0000u); }
__device__ __forceinline__ float wave_sum(float v) {
#pragma unroll
    for (int o = 1; o < 64; o <<= 1) v += __shfl_xor(v, o);
    return v;
}
__device__ __forceinline__ float silu(float g) { return g / (1.0f + __expf(-g)); }
__device__ __forceinline__ f32x4 mfma16(bf16x8 a, bf16x8 b, f32x4 c) { return __builtin_amdgcn_mfma_f32_16x16x32_bf16(a, b, c, 0, 0, 0); }
__device__ __forceinline__ f32x16 mfma32(bf16x8 a, bf16x8 b, f32x16 c) { return __builtin_amdgcn_mfma_f32_32x32x16_bf16(a, b, c, 0, 0, 0); }

struct EpiF32 {
    static constexpr bool PERM = false, AFTER_DRAIN = false;
    float* O; int ldc;
    __device__ __forceinline__ void operator()(const pg8::f32x4 (&acc)[2][2][4][2], const pg8::Unit& u, int wr, int wc, int fr, int fq) const {
        const int row0 = u.pm * 256 + wr * 64 + fr, col0 = u.pn * 256 + wc * 32 + 4 * fq;
#pragma unroll
        for (int ai = 0; ai < 2; ++ai)
#pragma unroll
            for (int m = 0; m < 4; ++m) { float* rowp = O + (size_t)(row0 + ai * 128 + m * 16) * ldc + col0;
#pragma unroll
                for (int bj = 0; bj < 2; ++bj)
#pragma unroll
                    for (int n = 0; n < 2; ++n) *(pg8::f32x4*)(rowp + bj * 128 + n * 16) = acc[ai][bj][m][n]; }
    }
};

struct Frame {
    LAS unsigned char* lds;
    volatile LAS unsigned* MISC;
    gu32* ctl;
    int tid, lane, wave;
    int vcu, G;
    unsigned char* ws;
    const float* x; const int* pos; const float* pre_norm; const float* post_norm;
    const float *w_in_even, *w_out_even, *w_in_odd, *diff_lambda, *diff_subln, *q_norm, *kv_norm, *w_uq, *w_ukv, *w_out_odd;
    float* out;
};

__device__ __forceinline__ void sincos_acc(float ang, float& s_out, float& c_out) {
    const double a = (double)ang;
    const double k = __builtin_rint(a * 0.63661977236758134308);
    double r = __builtin_fma(-k, 1.57079632679489655800, a);
    r = __builtin_fma(-k, 6.12323399573676603587e-17, r);
    const float x = (float)r, x2 = x * x;
    const float s = x + x * x2 * (-1.6666667163e-1f + x2 * (8.3333337680e-3f + x2 * (-1.9841270114e-4f + x2 * 2.7557314297e-6f)));
    const float c = 1.0f - 0.5f * x2 + x2 * x2 * (4.1666667908e-2f + x2 * (-1.3888889225e-3f + x2 * (2.4801587642e-5f - x2 * 2.7557314297e-7f)));
    const int q = ((int)k) & 3;
    s_out = (q == 0) ? s : (q == 1) ? c : (q == 2) ? -s : -c;
    c_out = (q == 0) ? c : (q == 1) ? -s : (q == 2) ? -c : s;
}

template <int MAP>
__device__ __forceinline__ int src_col(int n, int Nsrc) {
    if (MAP == 1) { if (n < 2048) return n; if (n < 3584) return n + 324; if (n < 3908) return n - 1536; return -1; }
    return n < Nsrc ? n : -1;
}
template <int MAP>
__device__ __forceinline__ void p0_transpose_item(const float* W, int K, int Nsrc, int Ndst, bf16* WT, LAS float* scr, int item, int lane) {
    const int nblk = Ndst / 32, kb = item / nblk, nb = item % nblk, k0 = 64 * kb, n0 = 32 * nb;
    const int sc = src_col<MAP>(n0 + (lane & 31), Nsrc);
#pragma unroll 8
    for (int i = 0; i < 32; ++i) { const int kk = 2 * i + (lane >> 5); scr[kk * 33 + (lane & 31)] = sc >= 0 ? W[(size_t)(k0 + kk) * Nsrc + sc] : 0.0f; }
    LDS_WAIT(); asm volatile("" ::: "memory");
    const int c = lane & 7;
#pragma unroll
    for (int j = 0; j < 4; ++j) { const int n = (lane >> 3) + 8 * j; const LAS float* s = scr + (8 * c) * 33 + n;
        v4u o; o.x = pk2(s[0 * 33], s[1 * 33]); o.y = pk2(s[2 * 33], s[3 * 33]); o.z = pk2(s[4 * 33], s[5 * 33]); o.w = pk2(s[6 * 33], s[7 * 33]);
        *(GAS v4u*)(WT + (size_t)(n0 + n) * K + k0 + 8 * c) = o; }
    LDS_WAIT(); asm volatile("" ::: "memory");
}
__device__ __forceinline__ void rms_row_to_bf16(const float* xrow, const float* gain, bf16* orow, int lane) {
    const GAS f32x4* xr = (const GAS f32x4*)xrow + lane; const GAS f32x4* gr = (const GAS f32x4*)gain + lane;
    f32x4 v[4]; float s = 0.f;
#pragma unroll
    for (int j = 0; j < 4; ++j) { v[j] = xr[64 * j]; s += (v[j].x * v[j].x + v[j].y * v[j].y) + (v[j].z * v[j].z + v[j].w * v[j].w); }
    const float r = 1.0f / sqrtf(wave_sum(s) * (1.f / DM) + NORM_EPS);
    GAS unsigned long long* o8 = (GAS unsigned long long*)orow + lane;
#pragma unroll
    for (int j = 0; j < 4; ++j) { const f32x4 g = gr[64 * j];
        o8[64 * j] = (unsigned long long)pk2(v[j].x * r * g.x, v[j].y * r * g.y) | ((unsigned long long)pk2(v[j].z * r * g.z, v[j].w * r * g.w) << 32); }
}

__device__ __forceinline__ void p0_prologue(Frame& F) {
    LAS float* scr = (LAS float*)(F.lds + RING_OFF + F.wave * 16384);
    const int gw = F.vcu * NWAVES + F.wave, NGW = F.G * NWAVES;
    constexpr int I_W0 = (DM / 64) * (N0 / 32), I_WO = (DM / 64) * (DM / 32), I_W1 = (DM / 64) * (N1 / 32), I_UQ = (256 / 64) * (768 / 32), I_UKV = (128 / 64) * (1024 / 32);
    constexpr int NITEMS = I_W0 + I_WO + I_W1 + I_UQ + I_UKV + I_WO;
    for (int it = gw; it < NITEMS; it += NGW) {
        int r = it;
        if (r < I_W0) { p0_transpose_item<1>(F.w_in_even, DM, EVEN_IN, N0, (bf16*)(F.ws + WS_W0T), scr, r, F.lane); continue; } r -= I_W0;
        if (r < I_WO) { p0_transpose_item<0>(F.w_out_even, DM, DM, DM, (bf16*)(F.ws + WS_WO0T), scr, r, F.lane); continue; } r -= I_WO;
        if (r < I_W1) { p0_transpose_item<0>(F.w_in_odd, DM, ODD_IN, N1, (bf16*)(F.ws + WS_W1T), scr, r, F.lane); continue; } r -= I_W1;
        if (r < I_UQ) { p0_transpose_item<0>(F.w_uq, 256, 768, 768, (bf16*)(F.ws + WS_WUQT), scr, r, F.lane); continue; } r -= I_UQ;
        if (r < I_UKV) { p0_transpose_item<0>(F.w_ukv, 128, 1024, 1024, (bf16*)(F.ws + WS_WUKVT), scr, r, F.lane); continue; } r -= I_UKV;
        p0_transpose_item<0>(F.w_out_odd, DM, DM, DM, (bf16*)(F.ws + WS_WO1T), scr, r, F.lane);
    }
    {
        float* cosB = (float*)(F.ws + WS_ROPE); float* sinB = cosB + (size_t)M * 32; float* cosD = sinB + (size_t)M * 32; float* sinD = cosD + (size_t)M * 16;
        const int gt = F.vcu * (NWAVES * 64) + F.tid, NGT = F.G * NWAVES * 64;
        for (int e = gt; e < M * 48; e += NGT) {
            const int t = e / 48, i = e % 48;
            const float p = (float)F.pos[t];
            if (i < 32) { const float inv = (float)::exp2(-(double)i * (13.287712379549449 / 32.0)); float s, c; sincos_acc(p * inv, s, c); cosB[(size_t)t * 32 + i] = c; sinB[(size_t)t * 32 + i] = s; }
            else { const int ii = i - 32; const float inv = (float)::exp2(-(double)ii * (13.287712379549449 / 16.0)); float s, c; sincos_acc(p * inv, s, c); cosD[(size_t)t * 16 + ii] = c; sinD[(size_t)t * 16 + ii] = s; }
        }
    }
    for (int m = gw; m < M; m += NGW) rms_row_to_bf16(F.x + (size_t)m * DM, F.pre_norm, (bf16*)(F.ws + WS_A) + (size_t)m * DM, F.lane);
}

template <bool NEXT>
__device__ __forceinline__ void post_norm_rows(Frame& F, const float* xin, const float* mbuf, const float* gpost, const float* gpre, float* xout, bf16* hn) {
    const int gw = F.vcu * NWAVES + F.wave, NGW = F.G * NWAVES, lane = F.lane;
    for (int row = gw; row < M; row += NGW) {
        const GAS f32x4* mr = (const GAS f32x4*)(mbuf + (size_t)row * DM) + lane; const GAS f32x4* xr = (const GAS f32x4*)(xin + (size_t)row * DM) + lane;
        const GAS f32x4* gp = (const GAS f32x4*)gpost + lane;
        f32x4 mv[4], xv[4]; float s = 0.f;
#pragma unroll
        for (int j = 0; j < 4; ++j) { mv[j] = mr[64 * j]; xv[j] = xr[64 * j]; s += (mv[j].x * mv[j].x + mv[j].y * mv[j].y) + (mv[j].z * mv[j].z + mv[j].w * mv[j].w); }
        const float r = 1.0f / sqrtf(wave_sum(s) * (1.f / DM) + NORM_EPS);
        float s2 = 0.f;
#pragma unroll
        for (int j = 0; j < 4; ++j) { const f32x4 g = gp[64 * j]; xv[j] = xv[j] + (mv[j] * r) * g; s2 += (xv[j].x * xv[j].x + xv[j].y * xv[j].y) + (xv[j].z * xv[j].z + xv[j].w * xv[j].w); }
        GAS f32x4* xo = (GAS f32x4*)(xout + (size_t)row * DM) + lane;
#pragma unroll
        for (int j = 0; j < 4; ++j) xo[64 * j] = xv[j];
        if (NEXT) {
            const float r2 = 1.0f / sqrtf(wave_sum(s2) * (1.f / DM) + NORM_EPS);
            const GAS f32x4* gq = (const GAS f32x4*)gpre + lane; GAS unsigned long long* o8 = (GAS unsigned long long*)(hn + (size_t)row * DM) + lane;
#pragma unroll
            for (int j = 0; j < 4; ++j) { const f32x4 g = gq[64 * j];
                o8[64 * j] = (unsigned long long)pk2(xv[j].x * r2 * g.x, xv[j].y * r2 * g.y) | ((unsigned long long)pk2(xv[j].z * r2 * g.z, xv[j].w * r2 * g.w) << 32); }
        }
    }
}

__device__ __forceinline__ float ret_lg2_precise(int h) {
    return h == 0 ? -0.04580368961312479f : h == 1 ? -0.02272007650008353f : h == 2 ? -0.011315313227834146f : -0.005646563141142063f; }

__device__ __forceinline__ void ret_rot8(const bf16* src, const float* cosB, const float* sinB, size_t trow, int hcol, int d0, float scale, float (&o1)[8], float (&o2)[8]) {
    const bf16* kp = src + trow * N0 + hcol;
    const v4u x1 = *(const GAS v4u*)(kp + d0), x2 = *(const GAS v4u*)(kp + 32 + d0);
    const GAS f32x4* cp = (const GAS f32x4*)(cosB + trow * 32 + d0); const GAS f32x4* sp = (const GAS f32x4*)(sinB + trow * 32 + d0);
    const f32x4 c0 = cp[0], c1 = cp[1], s0 = sp[0], s1 = sp[1];
    const float co[8] = {c0.x, c0.y, c0.z, c0.w, c1.x, c1.y, c1.z, c1.w}, si[8] = {s0.x, s0.y, s0.z, s0.w, s1.x, s1.y, s1.z, s1.w};
    const unsigned w1[4] = {x1.x, x1.y, x1.z, x1.w}, w2[4] = {x2.x, x2.y, x2.z, x2.w};
#pragma unroll
    for (int e = 0; e < 8; ++e) {
        const float a = (e & 1) ? bfhi(w1[e >> 1]) : bflo(w1[e >> 1]), b = (e & 1) ? bfhi(w2[e >> 1]) : bflo(w2[e >> 1]);
        o1[e] = (a * co[e] - b * si[e]) * scale; o2[e] = (a * si[e] + b * co[e]) * scale;
    }
}

__device__ __forceinline__ void ret_u_item(Frame& F, int item) {
    int tid_o = F.tid; asm volatile("" : "+v"(tid_o));
    const int n = item & 63, h = (item >> 6) & 3, b = item >> 8, tid = tid_o, lane = tid & 63, wave = F.wave;
    LAS bf16* KT = (LAS bf16*)(F.lds + RING_OFF); LAS bf16* VT = KT + 64 * 136;
    const bf16* P = (const bf16*)(F.ws + WS_B);
    const float* cosB = (const float*)(F.ws + WS_ROPE); const float* sinB = cosB + (size_t)M * 32;
    const float lg2 = ret_lg2_precise(h);
    {
        const int j = tid >> 2, d0 = (tid & 3) * 8; const size_t trow = (size_t)b * T + n * 128 + j;
        float o1[8], o2[8]; ret_rot8(P, cosB, sinB, trow, C0_BK + h * 64, d0, 0.125f * __builtin_amdgcn_exp2f((float)(127 - j) * lg2), o1, o2);
#pragma unroll
        for (int e = 0; e < 8; ++e) { KT[(d0 + e) * 136 + j] = (bf16)f2bf(o1[e]); KT[(32 + d0 + e) * 136 + j] = (bf16)f2bf(o2[e]); }
    }
#pragma unroll
    for (int i = 0; i < 4; ++i) {
        const int p = tid + 512 * i, j = p >> 4, c = (p & 15) * 8; const size_t trow = (size_t)b * T + n * 128 + j;
        const v4u x = *(const GAS v4u*)(P + trow * N0 + C0_BV + h * 128 + c); const unsigned w[4] = {x.x, x.y, x.z, x.w};
#pragma unroll
        for (int e = 0; e < 8; ++e) VT[(c + e) * 136 + j] = (bf16)((e & 1) ? (w[e >> 1] >> 16) : (w[e >> 1] & 0xffffu));
    }
    __syncthreads();
    const int dt = wave & 3, et0 = (wave >> 2) * 4, fr = lane & 15, fq = lane >> 4;
    f32x4 acc[4];
#pragma unroll
    for (int i = 0; i < 4; ++i) acc[i] = (f32x4){0.f, 0.f, 0.f, 0.f};
#pragma unroll
    for (int ks = 0; ks < 4; ++ks) {
        const bf16x8 a = *(const LAS bf16x8*)(KT + (16 * dt + fr) * 136 + 32 * ks + 8 * fq);
#pragma unroll
        for (int nt = 0; nt < 4; ++nt) { const bf16x8 bb = *(const LAS bf16x8*)(VT + (16 * (et0 + nt) + fr) * 136 + 32 * ks + 8 * fq); acc[nt] = mfma16(a, bb, acc[nt]); }
    }
    float* U = (float*)(F.ws + WS_U) + (size_t)((b * 4 + h) * 64 + n) * 8192;
#pragma unroll
    for (int nt = 0; nt < 4; ++nt)
#pragma unroll
        for (int r = 0; r < 4; ++r) U[(16 * dt + 4 * fq + r) * 128 + 16 * (et0 + nt) + fr] = acc[nt][r];
    __syncthreads();
}

__device__ __forceinline__ void ret_scan(Frame& F) {
    const int gt = F.vcu * (NWAVES * 64) + F.tid, NGT = F.G * NWAVES * 64;
    for (int e = gt; e < 8 * 8192; e += NGT) {
        const int bh = e >> 13, de = e & 8191, h = bh & 3;
        const float gch = __builtin_amdgcn_exp2f(128.0f * ret_lg2_precise(h));
        float* U = (float*)(F.ws + WS_U) + (size_t)bh * 64 * 8192 + de;
        float S = 0.f;
        for (int n0 = 0; n0 < 64; n0 += 8) {
            float v[8];
#pragma unroll
            for (int k = 0; k < 8; ++k) v[k] = U[(size_t)(n0 + k) * 8192];
#pragma unroll
            for (int k = 0; k < 8; ++k) { U[(size_t)(n0 + k) * 8192] = S; S = gch * S + v[k]; }
        }
    }
}

__device__ __forceinline__ void ret_out_item(Frame& F, int item) {
    int tid_o = F.tid; asm volatile("" : "+v"(tid_o));
    const int n = item & 63, h = (item >> 6) & 3, b = item >> 8, tid = tid_o, lane = tid & 63, wave = F.wave;
    LAS bf16* Qs = (LAS bf16*)(F.lds + RING_OFF); LAS bf16* Ks = Qs + 128 * 72; LAS bf16* VT = Ks + 128 * 72; LAS bf16* ST = VT + 128 * 136; LAS bf16* Ps = ST + 128 * 72;
    const bf16* P = (const bf16*)(F.ws + WS_B);
    const float* cosB = (const float*)(F.ws + WS_ROPE); const float* sinB = cosB + (size_t)M * 32;
    const float lg2 = ret_lg2_precise(h);
    {
        const int j = tid >> 2, d0 = (tid & 3) * 8; const size_t trow = (size_t)b * T + n * 128 + j;
        float o1[8], o2[8];
        ret_rot8(P, cosB, sinB, trow, C0_BQ + h * 64, d0, 1.0f, o1, o2);
        *(LAS v4u*)(Qs + j * 72 + d0) = (v4u){pk2(o1[0], o1[1]), pk2(o1[2], o1[3]), pk2(o1[4], o1[5]), pk2(o1[6], o1[7])};
        *(LAS v4u*)(Qs + j * 72 + 32 + d0) = (v4u){pk2(o2[0], o2[1]), pk2(o2[2], o2[3]), pk2(o2[4], o2[5]), pk2(o2[6], o2[7])};
        ret_rot8(P, cosB, sinB, trow, C0_BK + h * 64, d0, 0.125f, o1, o2);
        *(LAS v4u*)(Ks + j * 72 + d0) = (v4u){pk2(o1[0], o1[1]), pk2(o1[2], o1[3]), pk2(o1[4], o1[5]), pk2(o1[6], o1[7])};
        *(LAS v4u*)(Ks + j * 72 + 32 + d0) = (v4u){pk2(o2[0], o2[1]), pk2(o2[2], o2[3]), pk2(o2[4], o2[5]), pk2(o2[6], o2[7])};
    }
#pragma unroll
    for (int i = 0; i < 4; ++i) {
        const int p = tid + 512 * i, j = p >> 4, c = (p & 15) * 8; const size_t trow = (size_t)b * T + n * 128 + j;
        const v4u x = *(const GAS v4u*)(P + trow * N0 + C0_BV + h * 128 + c); const unsigned w[4] = {x.x, x.y, x.z, x.w};
#pragma unroll
        for (int e = 0; e < 8; ++e) VT[(c + e) * 136 + j] = (bf16)((e & 1) ? (w[e >> 1] >> 16) : (w[e >> 1] & 0xffffu));
    }
    {
        const float* U = (const float*)(F.ws + WS_U) + (size_t)((b * 4 + h) * 64 + n) * 8192;
#pragma unroll
        for (int i = 0; i < 4; ++i) {
            const int idx = tid + 512 * i, d = idx >> 5, e4 = (idx & 31) * 4;
            const f32x4 sv = *(const GAS f32x4*)(U + d * 128 + e4);
            ST[(e4 + 0) * 72 + d] = (bf16)f2bf(sv.x); ST[(e4 + 1) * 72 + d] = (bf16)f2bf(sv.y); ST[(e4 + 2) * 72 + d] = (bf16)f2bf(sv.z); ST[(e4 + 3) * 72 + d] = (bf16)f2bf(sv.w);
        }
    }
    __syncthreads();
    const int i0 = 16 * wave, fr = lane & 15, fq = lane >> 4;
    bf16x8 aq[2];
#pragma unroll
    for (int ks = 0; ks < 2; ++ks) aq[ks] = *(const LAS bf16x8*)(Qs + (i0 + fr) * 72 + 32 * ks + 8 * fq);
#pragma unroll
    for (int jt = 0; jt < 8; ++jt) {
        f32x4 acc = (f32x4){0.f, 0.f, 0.f, 0.f};
#pragma unroll
        for (int ks = 0; ks < 2; ++ks) { const bf16x8 bb = *(const LAS bf16x8*)(Ks + (16 * jt + fr) * 72 + 32 * ks + 8 * fq); acc = mfma16(aq[ks], bb, acc); }
#pragma unroll
        for (int r = 0; r < 4; ++r) { const int i = i0 + 4 * fq + r, j = 16 * jt + fr;
            const float dcy = (i >= j) ? __builtin_amdgcn_exp2f((float)(i - j) * lg2) : 0.f; Ps[i * 136 + j] = (bf16)f2bf(acc[r] * dcy); }
    }
    __syncthreads();
    f32x4 oi[8], oc[8];
#pragma unroll
    for (int et = 0; et < 8; ++et) { oi[et] = (f32x4){0.f, 0.f, 0.f, 0.f}; oc[et] = (f32x4){0.f, 0.f, 0.f, 0.f}; }
#pragma unroll
    for (int ks = 0; ks < 4; ++ks) {
        const bf16x8 ap = *(const LAS bf16x8*)(Ps + (i0 + fr) * 136 + 32 * ks + 8 * fq);
#pragma unroll
        for (int et = 0; et < 8; ++et) { const bf16x8 bb = *(const LAS bf16x8*)(VT + (16 * et + fr) * 136 + 32 * ks + 8 * fq); oi[et] = mfma16(ap, bb, oi[et]); }
    }
#pragma unroll
    for (int ks = 0; ks < 2; ++ks)
#pragma unroll
        for (int et = 0; et < 8; ++et) { const bf16x8 bb = *(const LAS bf16x8*)(ST + (16 * et + fr) * 72 + 32 * ks + 8 * fq); oc[et] = mfma16(aq[ks], bb, oc[et]); }
    bf16* MIX = (bf16*)(F.ws + WS_A);
#pragma unroll
    for (int r = 0; r < 4; ++r) {
        const int i = i0 + 4 * fq + r; const float xi = __builtin_amdgcn_exp2f((float)(i + 1) * lg2);
        float v[8]; float s = 0.f;
#pragma unroll
        for (int et = 0; et < 8; ++et) { v[et] = oi[et][r] + xi * oc[et][r]; s += v[et]; }
        s += __shfl_xor(s, 1); s += __shfl_xor(s, 2); s += __shfl_xor(s, 4); s += __shfl_xor(s, 8);
        const float mu = s * (1.f / 128.f); float q = 0.f;
#pragma unroll
        for (int et = 0; et < 8; ++et) { v[et] -= mu; q += v[et] * v[et]; }
        q += __shfl_xor(q, 1); q += __shfl_xor(q, 2); q += __shfl_xor(q, 4); q += __shfl_xor(q, 8);
        const float rstd = 1.0f / sqrtf(q * (1.f / 128.f) + NORM_EPS);
        const size_t trow = (size_t)b * T + n * 128 + i;
#pragma unroll
        for (int et = 0; et < 8; ++et) { const int e = 16 * et + fr; const float g = bf2f(P[trow * N0 + C0_BG + h * 128 + e]);
            MIX[trow * DM + 512 + h * 128 + e] = (bf16)f2bf(v[et] * rstd * silu(g)); }
    }
    __syncthreads();
}

constexpr int IDX_CAP = 768;
template <int PASS>
__device__ __forceinline__ void idx_pass(const bf16x8 (&qa)[4][4], const LAS f32x4* wtab, const bf16* Kb, int g, LAS unsigned* hist, LAS unsigned* info, LAS unsigned* lcnt, int wave, int lane) {
    const int r = lane & 31, hh = lane >> 5, ntile = g + 1;
    LAS unsigned* img = hist;
    LAS unsigned* lst = hist + 32 * 256;
    bf16x8 kb[4];
    int kt = wave;
    const unsigned klane = (unsigned)(r * N0 + 8 * hh);
    if (kt < ntile) { const bf16* kp = Kb + (size_t)(32 * kt) * N0;
#pragma unroll
        for (int ks = 0; ks < 4; ++ks) kb[ks] = *(const GAS bf16x8*)(kp + klane + 16 * ks); }
    for (; kt < ntile; kt += 8) {
        bf16x8 kn[4];
        if (kt + 8 < ntile) { const bf16* kp = Kb + (size_t)(32 * (kt + 8)) * N0;
#pragma unroll
            for (int ks = 0; ks < 4; ++ks) kn[ks] = *(const GAS bf16x8*)(kp + klane + 16 * ks); }
        else {
#pragma unroll
            for (int ks = 0; ks < 4; ++ks) kn[ks] = kb[ks]; }
        const int s = 32 * kt + r; const bool diag = (kt == g);
#pragma unroll
        for (int m = 0; m < 4; ++m) {
            f32x16 acc;
#pragma unroll
            for (int q = 0; q < 16; ++q) acc[q] = 0.f;
#pragma unroll
            for (int ks = 0; ks < 4; ++ks) acc = mfma32(qa[m][ks], kb[ks], acc);
#pragma unroll
            for (int i = 0; i < 4; ++i) {
                const f32x4 w4 = wtab[8 * m + 4 * hh + i];
                float sc = __builtin_fmaf(w4.x, __builtin_fmaxf(acc[i], 0.f), 0.0f);
                sc = __builtin_fmaf(w4.y, __builtin_fmaxf(acc[4 + i], 0.f), sc);
                sc = __builtin_fmaf(w4.z, __builtin_fmaxf(acc[8 + i], 0.f), sc);
                sc = __builtin_fmaf(w4.w, __builtin_fmaxf(acc[12 + i], 0.f), sc);
                const unsigned u = __builtin_bit_cast(unsigned, sc);
                unsigned key = u ^ ((unsigned)((int)u >> 31) | 0x80000000u);
                key = (key & 0xFFFFE000u) | (unsigned)(8191 - s);
                const int row = 8 * m + 4 * hh + i;
                const bool valid = !diag || (r <= row);
                if (PASS == 1) { if (valid) { const unsigned bin = key >> 21; __hip_atomic_fetch_add(hist + row * 1024 + (bin >> 1), 1u << ((bin & 1u) * 16u), __ATOMIC_RELAXED, __HIP_MEMORY_SCOPE_WORKGROUP); } }
                if (PASS == 2) { if (valid && (key >> 21) == info[row]) { const unsigned bin = (key >> 10) & 2047u; __hip_atomic_fetch_add(hist + row * 1024 + (bin >> 1), 1u << ((bin & 1u) * 16u), __ATOMIC_RELAXED, __HIP_MEMORY_SCOPE_WORKGROUP); } }
                if (PASS == 3) { if (valid && (key >> 10) == info[row]) { const unsigned bin = key & 1023u; __hip_atomic_fetch_add(hist + row * 1024 + (bin >> 1), 1u << ((bin & 1u) * 16u), __ATOMIC_RELAXED, __HIP_MEMORY_SCOPE_WORKGROUP); } }
                if (PASS == 5 || PASS == 6) {
                    bool def;
                    if (PASS == 5) { const unsigned k11 = key >> 21, b1 = info[row]; def = valid && (k11 > b1);
                        if (valid && (k11 == b1)) { const unsigned pos = __hip_atomic_fetch_add(lcnt + row, 1u, __ATOMIC_RELAXED, __HIP_MEMORY_SCOPE_WORKGROUP); lst[row * IDX_CAP + pos] = key; } }
                    else def = valid && (key >= info[row]);
                    const unsigned long long bm = __ballot(def);
                    if (lane == 0) { img[(8 * m + i) * 256 + kt] = (unsigned)bm; img[(8 * m + 4 + i) * 256 + kt] = (unsigned)(bm >> 32); }
                }
            }
            __builtin_amdgcn_sched_barrier(0);
        }
#pragma unroll
        for (int ks = 0; ks < 4; ++ks) kb[ks] = kn[ks];
    }
}

template <int L>
__device__ __forceinline__ void idx_scan(LAS unsigned* hist, LAS unsigned* info, LAS unsigned* need, LAS unsigned* ccnt, int wave, int lane) {
    constexpr int NB = (L == 3) ? 1024 : 2048, BPL = NB / 64, WPL = BPL / 2;
#pragma unroll 1
    for (int rr = 0; rr < 4; ++rr) {
        const int row = 4 * wave + rr;
        const LAS unsigned* hp = hist + row * 1024 + lane * WPL;
        unsigned wds[WPL]; unsigned cnt = 0u;
#pragma unroll
        for (int k = 0; k < WPL; ++k) { wds[k] = hp[k]; cnt += (wds[k] & 0xffffu) + (wds[k] >> 16); }
        unsigned x = cnt;
#pragma unroll
        for (int off = 1; off < 64; off <<= 1) { const unsigned y = (unsigned)__shfl_down((int)x, off); if (lane + off < 64) x += y; }
        const unsigned S = x - cnt, nd = need[row];
        const bool hit = (S < nd) && (S + cnt >= nd);
        unsigned run = S; int fb = -1; unsigned fn = 0u, fc = 0u;
#pragma unroll
        for (int bi = BPL - 1; bi >= 0; --bi) {
            const unsigned c = (bi & 1) ? (wds[bi >> 1] >> 16) : (wds[bi >> 1] & 0xffffu);
            const bool here = (fb < 0) && (run + c >= nd);
            if (here) { fb = bi; fn = nd - run; fc = c; }
            run += c;
        }
        if (hit) {
            const unsigned bin = (unsigned)(lane * BPL + fb);
            if (L == 1) { info[row] = bin; need[row] = fn; ccnt[row] = fc; }
            if (L == 2) { info[row] = (info[row] << 11) | bin; need[row] = fn; }
            if (L == 3) { info[row] = (info[row] << 10) | bin; }
        }
    }
}

__device__ __forceinline__ void idx_zero(LAS unsigned* p, int n16, int tid) {
    LAS v4u* h4 = (LAS v4u*)p;
    for (int i = tid; i < n16; i += 512) h4[i] = (v4u){0u, 0u, 0u, 0u};
}

__device__ __forceinline__ void idx_item(Frame& F, int b, int g) {
    LAS unsigned* hist = (LAS unsigned*)(F.lds + RING_OFF);
    LAS unsigned* info = (LAS unsigned*)(F.lds + INFO_OFF);
    LAS unsigned* need = info + 32; LAS unsigned* ccnt = info + 64; LAS unsigned* lcnt = info + 96;
    LAS f32x4* wtab = (LAS f32x4*)(info + 128);
    int tid_o = F.tid; asm volatile("" : "+v"(tid_o));
    const int tid = tid_o, lane = tid & 63, wave = F.wave, r = lane & 31, hh = lane >> 5;
    const bf16* Pb = (const bf16*)(F.ws + WS_B) + (size_t)b * T * N0;
    bf16x8 qa[4][4];
#pragma unroll
    for (int m = 0; m < 4; ++m) {
        const bf16* qp = Pb + (size_t)(32 * g + 8 * m + (r & 7)) * N0 + C0_IQ + (r >> 3) * 64 + 8 * hh;
#pragma unroll
        for (int ks = 0; ks < 4; ++ks) qa[m][ks] = *(const GAS bf16x8*)(qp + 16 * ks);
    }
    if (tid < 32) { const u32x2 wp = *(const GAS u32x2*)(Pb + (size_t)(32 * g + tid) * N0 + C0_IW); wtab[tid] = (f32x4){bflo(wp.x), bfhi(wp.x), bflo(wp.y), bfhi(wp.y)}; }
    const bf16* Kb = Pb + C0_IK;
    LAS unsigned* img = hist; LAS unsigned* lst = hist + 32 * 256;
    if (g >= 8) {
        idx_zero(hist, 8192, tid); if (tid < 32) { info[tid] = 0u; need[tid] = 256u; ccnt[tid] = 0u; lcnt[tid] = 0u; }
        __syncthreads();
        idx_pass<1>(qa, wtab, Kb, g, hist, info, lcnt, wave, lane);
        __syncthreads();
        idx_scan<1>(hist, info, need, ccnt, wave, lane);
        __syncthreads();
        unsigned cmax = 0u;
#pragma unroll
        for (int i = 0; i < 32; ++i) cmax = max(cmax, ccnt[i]);
        const bool fast = (unsigned)__builtin_amdgcn_readfirstlane((int)cmax) <= (unsigned)IDX_CAP;
        __syncthreads();
        if (fast) {
            idx_zero(img, 2048, tid);
            __syncthreads();
            idx_pass<5>(qa, wtab, Kb, g, hist, info, lcnt, wave, lane);
            __syncthreads();
#pragma unroll 1
            for (int rr = 0; rr < 4; ++rr) {
                const int row = 4 * wave + rr;
                const unsigned n = lcnt[row], nd = need[row]; unsigned prefix = info[row] << 21;
                const LAS unsigned* lp = lst + row * IDX_CAP;
#pragma unroll 1
                for (int bit = 20; bit >= 0; --bit) {
                    const unsigned cand = prefix | (1u << bit); unsigned c = 0u;
                    for (unsigned j0 = 0; j0 < n; j0 += 64) { const unsigned j = j0 + lane; const unsigned k = (j < n) ? lp[j] : 0u; c += (unsigned)__popcll(__ballot(k >= cand)); }
                    if (c >= nd) prefix = cand;
                }
                for (unsigned j0 = 0; j0 < n; j0 += 64) { const unsigned j = j0 + lane;
                    if (j < n) { const unsigned k = lp[j]; if (k >= prefix) { const unsigned s = 8191u - (k & 8191u);
                        __hip_atomic_fetch_or(img + row * 256 + (s >> 5), 1u << (s & 31u), __ATOMIC_RELAXED, __HIP_MEMORY_SCOPE_WORKGROUP); } } }
            }
        } else {
            idx_zero(hist, 8192, tid);
            __syncthreads();
            idx_pass<2>(qa, wtab, Kb, g, hist, info, lcnt, wave, lane);
            __syncthreads();
            idx_scan<2>(hist, info, need, ccnt, wave, lane);
            __syncthreads();
            idx_zero(hist, 8192, tid);
            __syncthreads();
            idx_pass<3>(qa, wtab, Kb, g, hist, info, lcnt, wave, lane);
            __syncthreads();
            idx_scan<3>(hist, info, need, ccnt, wave, lane);
            __syncthreads();
            idx_zero(img, 2048, tid);
            __syncthreads();
            idx_pass<6>(qa, wtab, Kb, g, hist, info, lcnt, wave, lane);
        }
    } else {
        idx_zero(img, 2048, tid); if (tid < 32) info[tid] = 0u;
        __syncthreads();
        idx_pass<6>(qa, wtab, Kb, g, hist, info, lcnt, wave, lane);
    }
    __syncthreads();
    { v4u* dst = (v4u*)((unsigned*)(F.ws + WS_MASK) + ((size_t)b * T + 32 * g) * 256); const LAS v4u* src = (const LAS v4u*)img;
#pragma unroll
      for (int i = 0; i < 4; ++i) dst[tid + 512 * i] = src[tid + 512 * i]; }
    __syncthreads();
}

namespace att {
#define SBAR() __builtin_amdgcn_sched_barrier(0)
__device__ __forceinline__ int crow(int r, int hi) { return (r & 3) + 8 * (r >> 2) + 4 * hi; }
__device__ __forceinline__ unsigned cvtpk(float lo, float hi) { unsigned r; asm volatile("v_cvt_pk_bf16_f32 %0, %1, %2" : "=v"(r) : "v"(lo), "v"(hi)); return r; }

constexpr float THR2 = 11.5f;
__device__ __forceinline__ void partialSM(f32x16& p0, f32x16& p1, float& m_reg, float& alpha, bool first) {
    float pmax = p0[0];
#pragma unroll
    for (int r = 1; r < 16; ++r) pmax = fmaxf(pmax, p0[r]);
#pragma unroll
    for (int r = 0; r < 16; ++r) pmax = fmaxf(pmax, p1[r]);
    { auto rr = __builtin_amdgcn_permlane32_swap(__float_as_uint(pmax), __float_as_uint(pmax), false, false);
      pmax = fmaxf(__uint_as_float(rr[0]), __uint_as_float(rr[1])); }
    alpha = 1.f;
    if (__builtin_expect(first || !__all(pmax <= THR2), 0)) {
        const float delta = first ? (pmax > -1e30f ? pmax : 0.f) : fmaxf(pmax, 0.f);
#pragma unroll
        for (int r = 0; r < 16; ++r) { p0[r] -= delta; p1[r] -= delta; }
        m_reg += delta; if (!first) alpha = __builtin_amdgcn_exp2f(-delta);
    }
#pragma unroll
    for (int r = 0; r < 16; ++r) p0[r] = __builtin_amdgcn_exp2f(p0[r]);
}
__device__ __forceinline__ void finishSM(f32x16& p0, f32x16& p1, float alpha, float& l_reg, bf16x8& pa0, bf16x8& pa1, bf16x8& pa2, bf16x8& pa3) {
#pragma unroll
    for (int r = 0; r < 16; ++r) p1[r] = __builtin_amdgcn_exp2f(p1[r]);
    float ps = 0;
#pragma unroll
    for (int r = 0; r < 16; ++r) ps += p0[r];
#pragma unroll
    for (int r = 0; r < 16; ++r) ps += p1[r];
    { auto rr = __builtin_amdgcn_permlane32_swap(__float_as_uint(ps), __float_as_uint(ps), false, false);
      ps = __uint_as_float(rr[0]) + __uint_as_float(rr[1]); }
    l_reg = l_reg * alpha + ps;
#define PK4(P, BASE, OUT) do { unsigned a0 = cvtpk(P[BASE + 0], P[BASE + 1]), a1 = cvtpk(P[BASE + 2], P[BASE + 3]);   \
    unsigned b0 = cvtpk(P[BASE + 4], P[BASE + 5]), b1 = cvtpk(P[BASE + 6], P[BASE + 7]);                              \
    auto r0 = __builtin_amdgcn_permlane32_swap(a0, b0, false, false); auto r1 = __builtin_amdgcn_permlane32_swap(a1, b1, false, false); \
    v4u w = {r0[0], r1[0], r0[1], r1[1]}; OUT = __builtin_bit_cast(bf16x8, w); } while (0)
    PK4(p0, 0, pa0); PK4(p0, 8, pa1); PK4(p1, 0, pa2); PK4(p1, 8, pa3);
#undef PK4
}
template <int ND0, bool MASKED>
__device__ __forceinline__ void qkt(f32x16& p0, f32x16& p1, const LAS char* Kb, const bf16x8 (&qr)[ND0], int r32, int hi, u32x2 mw, float m_reg, const f32x16& negm) {
    if constexpr (MASKED) {
        const unsigned x0 = (~mw.x) >> (4 * hi), x1 = (~mw.y) >> (4 * hi), nm = __builtin_bit_cast(unsigned, -m_reg);
#pragma unroll
        for (int q = 0; q < 16; ++q) { const int c = (q & 3) + 8 * (q >> 2);
            const unsigned s0 = (unsigned)__builtin_amdgcn_sbfe((int)x0, c, 1), s1 = (unsigned)__builtin_amdgcn_sbfe((int)x1, c, 1);
            p0[q] = __builtin_bit_cast(float, (s0 & 0xFF800000u) | (~s0 & nm));
            p1[q] = __builtin_bit_cast(float, (s1 & 0xFF800000u) | (~s1 & nm)); }
    }
#pragma unroll
    for (int d0 = 0; d0 < ND0; ++d0) {
        const bf16x8 b0 = *(const LAS bf16x8*)(Kb + (2 * d0 + hi) * 1024 + r32 * 16);
        const bf16x8 b1 = *(const LAS bf16x8*)(Kb + (2 * d0 + hi) * 1024 + (32 + r32) * 16);
        if (!MASKED && d0 == 0) { p0 = mfma32(b0, qr[0], negm); p1 = mfma32(b1, qr[0], negm); }
        else { p0 = mfma32(b0, qr[d0], p0); p1 = mfma32(b1, qr[d0], p1); } }
}
template <int NCB> __device__ __forceinline__ int v_st(int k, int c) { const int kk = (k & ~0xC) | ((k & 4) << 1) | ((k & 8) >> 1); return ((kk >> 3) * NCB + (c >> 5)) * 512 + ((kk & 7) * 32 + (c & 31)) * 2; }
__device__ __forceinline__ int v_rd_base(int lane) { return ((lane & 3) << 3) | (((lane >> 2) & 3) << 6) | (((lane >> 4) & 1) << 5) | (((lane >> 5) & 1) << 8); }
template <int OFF> __device__ __forceinline__ s16x4 tr_read(int vb) { s16x4 r; asm volatile("ds_read_b64_tr_b16 %0, %1 offset:%2" : "=&v"(r) : "v"(vb), "i"(OFF) : "memory"); return r; }
template <int NCB, int D0> __device__ __forceinline__ void pv_one(f32x16& od, int vb, bf16x8 pa0, bf16x8 pa1, bf16x8 pa2, bf16x8 pa3) {
    constexpr int KS = NCB * 1024, HF = NCB * 512, B0 = D0 * 512;
    const s16x4 l0 = tr_read<B0>(vb), h0 = tr_read<B0 + HF>(vb), l1 = tr_read<B0 + KS>(vb), h1 = tr_read<B0 + KS + HF>(vb);
    const s16x4 l2 = tr_read<B0 + 2 * KS>(vb), h2 = tr_read<B0 + 2 * KS + HF>(vb), l3 = tr_read<B0 + 3 * KS>(vb), h3 = tr_read<B0 + 3 * KS + HF>(vb);
    asm volatile("s_waitcnt lgkmcnt(0)" ::: "memory"); SBAR();
#define PK(L, H) (bf16x8){L[0], L[1], L[2], L[3], H[0], H[1], H[2], H[3]}
    od = mfma32(pa0, PK(l0, h0), od);
    od = mfma32(pa1, PK(l1, h1), od);
    od = mfma32(pa2, PK(l2, h2), od);
    od = mfma32(pa3, PK(l3, h3), od);
#undef PK
}
template <int NCB> __device__ __forceinline__ void pv_all(f32x16 (&o)[NCB], int vb, bf16x8 pa0, bf16x8 pa1, bf16x8 pa2, bf16x8 pa3) {
    pv_one<NCB, 0>(o[0], vb, pa0, pa1, pa2, pa3); pv_one<NCB, 1>(o[1], vb, pa0, pa1, pa2, pa3);
    if constexpr (NCB == 4) { pv_one<NCB, 2>(o[2], vb, pa0, pa1, pa2, pa3); pv_one<NCB, 3>(o[3], vb, pa0, pa1, pa2, pa3); }
}
__device__ __forceinline__ void cmask(f32x16& p0, f32x16& p1, int jb, int qrel, int hi) {
    const float NEG = -INFINITY; const int d = qrel - 64 * jb - 4 * hi;
#pragma unroll
    for (int r = 0; r < 16; ++r) { const int c = (r & 3) + 8 * (r >> 2); if (c > d) p0[r] = NEG; if (c + 32 > d) p1[r] = NEG; }
}
struct AttnP {
    const bf16* Q; const bf16* K; const bf16* K2; const bf16* V; bf16* O; const bf16* G; const unsigned* mask; const float* cs; const float* sn;
    int ldq, ldk, ldk2, ldv, ldo, ldg; float C;
};
template <int DQK, int DV, bool MASKED, bool GATED, bool ROPEQ>
__device__ __forceinline__ void attn_unit(const AttnP& P, int qb, LAS char* lds, int tid_in) {
    int tid = tid_in; asm volatile("" : "+v"(tid));
    constexpr int ND0 = DQK / 16, NCB = DV / 32, KB_BYTES = DQK * 128, VB_BYTES = 64 * DV * 2, NK = (8 * DQK + 511) / 512, NV = (8 * DV) / 512;
    const int wid = __builtin_amdgcn_readfirstlane(tid >> 6), lane = tid & 63, r32 = lane & 31, hi = lane >> 5;
    LAS char* Vl = lds; LAS char* Kl = lds + 2 * VB_BYTES;
    LAS float* ws = (LAS float*)(lds + 2 * VB_BYTES + 2 * KB_BYTES) + wid * 64; LAS float* li_l = ws; LAS float* al_l = ws + 32;
    LAS bf16* stg = (LAS bf16*)(lds + 2 * VB_BYTES + 2 * KB_BYTES + 2048) + wid * (32 * DV);
    const int q0 = qb * 256;
    float m_reg = 0.f, l_reg = 0.f; f32x16 negm;
#pragma unroll
    for (int q = 0; q < 16; ++q) negm[q] = 0.f; f32x16 o[NCB]; bf16x8 qr[ND0];
#pragma unroll
    for (int d = 0; d < NCB; ++d)
#pragma unroll
        for (int q = 0; q < 16; ++q) o[d][q] = 0.f;
    {
        const bf16* Qw = P.Q + (size_t)(q0 + wid * 32 + r32) * P.ldq + hi * 8;
#pragma unroll
        for (int d0 = 0; d0 < ND0; ++d0) qr[d0] = *(const GAS bf16x8*)(Qw + d0 * 16);
        if constexpr (ROPEQ) {
            const float* cp = P.cs + (size_t)(q0 + wid * 32 + r32) * 16 + 8 * hi; const float* sp = P.sn + (size_t)(q0 + wid * 32 + r32) * 16 + 8 * hi;
            const f32x4 c0 = *(const GAS f32x4*)cp, c1 = *(const GAS f32x4*)(cp + 4), s0 = *(const GAS f32x4*)sp, s1 = *(const GAS f32x4*)(sp + 4);
            const float co[8] = {c0.x, c0.y, c0.z, c0.w, c1.x, c1.y, c1.z, c1.w}, si[8] = {s0.x, s0.y, s0.z, s0.w, s1.x, s1.y, s1.z, s1.w};
            bf16x8 a = qr[ND0 - 2], bq = qr[ND0 - 1];
#pragma unroll
            for (int j = 0; j < 8; ++j) { const float x1 = bf2f((bf16)a[j]), x2 = bf2f((bf16)bq[j]);
                a[j] = (short)f2bf(x1 * co[j] - x2 * si[j]); bq[j] = (short)f2bf(x1 * si[j] + x2 * co[j]); }
            qr[ND0 - 2] = a; qr[ND0 - 1] = bq;
        }
    }
    unsigned kofg[NK]; int koff[NK]; bool kval[NK];
    { const int row = 8 * (tid >> 6) + (tid & 7), c = (tid & 63) >> 3; kofg[0] = (unsigned)(row * P.ldk + c * 8); koff[0] = c * 1024 + row * 16; kval[0] = true; }
    if constexpr (NK == 2) { const int row = 8 * ((tid & 255) >> 5) + (tid & 7), c = (tid & 31) >> 3; kofg[1] = (unsigned)(row * P.ldk2 + c * 8); koff[1] = (8 + c) * 1024 + row * 16; kval[1] = tid < 256; }
    unsigned vofg[NV]; int voff[NV];
#pragma unroll
    for (int i = 0; i < NV; ++i) { const int p = tid + 512 * i, row = p / (DV / 8), c8 = (p % (DV / 8)) * 8; voff[i] = v_st<NCB>(row, c8); vofg[i] = (unsigned)(row * P.ldv + c8); }
    const int vb0 = (int)(unsigned)(uintptr_t)Vl + v_rd_base(lane);
    const unsigned* mrow = MASKED ? P.mask + (size_t)(q0 + wid * 32 + r32) * 256 : nullptr;
    bf16x8 ksr[NK], vsr[NV]; u32x2 mw = {0u, 0u}, mwn = {0u, 0u};
#define SLOAD(k0) do { { const bf16* kb_u = P.K + (size_t)(k0) * P.ldk; ksr[0] = *(const GAS bf16x8*)(kb_u + kofg[0]); } \
    if constexpr (NK == 2) { const bf16* kb2_u = P.K2 + (size_t)(k0) * P.ldk2; if (kval[1]) ksr[1] = *(const GAS bf16x8*)(kb2_u + kofg[1]); } \
    { const bf16* vb_u = P.V + (size_t)(k0) * P.ldv; _Pragma("unroll") for (int i_ = 0; i_ < NV; ++i_) vsr[i_] = *(const GAS bf16x8*)(vb_u + vofg[i_]); } \
    if (MASKED) { DBG_MWLOAD(k0); } } while (0)
#define SWRITE(b) do { _Pragma("unroll") for (int i_ = 0; i_ < NK; ++i_) if (kval[i_]) *(LAS bf16x8*)(Kl + (b) * KB_BYTES + koff[i_]) = ksr[i_]; \
    _Pragma("unroll") for (int i_ = 0; i_ < NV; ++i_) *(LAS bf16x8*)(Vl + (b) * VB_BYTES + voff[i_]) = vsr[i_]; mw = mwn; } while (0)
#define SWAIT() asm volatile("s_waitcnt vmcnt(0)" ::: "memory")
#define NEGM() do { if (!MASKED) { _Pragma("unroll") for (int q_ = 0; q_ < 16; ++q_) negm[q_] = -m_reg; } } while (0)
#define RESC(a) do { if (__any((a) < 1.f)) { NEGM(); if (hi == 0) al_l[r32] = (a); asm volatile("s_waitcnt lgkmcnt(0)" ::: "memory"); \
    _Pragma("unroll") for (int d_ = 0; d_ < NCB; ++d_) _Pragma("unroll") for (int r_ = 0; r_ < 16; ++r_) o[d_][r_] *= al_l[crow(r_, hi)]; } } while (0)
    const int NT = (q0 + 256) / 64, qrel = wid * 32 + r32;
#define DBG_MWLOAD(k0) mwn = *(const GAS u32x2*)(mrow + ((k0) >> 5))
#define MASKT(P0, P1, t) do { if (!MASKED) { const int jb_ = (t) - (NT - 4); if (jb_ >= 0) cmask(P0, P1, jb_, qrel, hi); } } while (0)
    f32x16 pA0, pA1, pB0, pB1; float alA, alB; bf16x8 pa0, pa1, pa2, pa3;
    SLOAD(0); SWAIT(); SWRITE(0); __syncthreads();
    qkt<ND0, MASKED>(pA0, pA1, Kl, qr, r32, hi, mw, m_reg, negm); MASKT(pA0, pA1, 0); partialSM(pA0, pA1, m_reg, alA, true); NEGM();
    SLOAD(64); SWAIT(); SWRITE(1); __syncthreads();
    for (int j = 1; j + 1 < NT; j += 2) {
        SBAR(); qkt<ND0, MASKED>(pB0, pB1, Kl + KB_BYTES, qr, r32, hi, mw, m_reg, negm); MASKT(pB0, pB1, j);
        finishSM(pA0, pA1, alA, l_reg, pa0, pa1, pa2, pa3); SBAR();
        SLOAD((j + 1) * 64); SBAR();
        pv_all<NCB>(o, vb0, pa0, pa1, pa2, pa3); partialSM(pB0, pB1, m_reg, alB, false);
        __syncthreads(); SWAIT(); SWRITE(0);
        RESC(alB); __syncthreads();
        SBAR(); qkt<ND0, MASKED>(pA0, pA1, Kl, qr, r32, hi, mw, m_reg, negm); MASKT(pA0, pA1, j + 1);
        finishSM(pB0, pB1, alB, l_reg, pa0, pa1, pa2, pa3); SBAR();
        SLOAD((j + 2) * 64); SBAR();
        pv_all<NCB>(o, vb0 + VB_BYTES, pa0, pa1, pa2, pa3); partialSM(pA0, pA1, m_reg, alA, false);
        __syncthreads(); SWAIT(); SWRITE(1);
        RESC(alA); __syncthreads();
    }
    SBAR(); qkt<ND0, MASKED>(pB0, pB1, Kl + KB_BYTES, qr, r32, hi, mw, m_reg, negm); MASKT(pB0, pB1, NT - 1);
    finishSM(pA0, pA1, alA, l_reg, pa0, pa1, pa2, pa3); SBAR();
    pv_all<NCB>(o, vb0, pa0, pa1, pa2, pa3); partialSM(pB0, pB1, m_reg, alB, false);
    RESC(alB);
    finishSM(pB0, pB1, alB, l_reg, pa0, pa1, pa2, pa3); SBAR();
    pv_all<NCB>(o, vb0 + VB_BYTES, pa0, pa1, pa2, pa3);
    int lane_e = lane; asm volatile("" : "+v"(lane_e));
    const int r32e = lane_e & 31, hie = lane_e >> 5;
    if (hie == 0) li_l[r32e] = l_reg;
    asm volatile("s_waitcnt lgkmcnt(0)" ::: "memory");
    const size_t orow0 = (size_t)(q0 + wid * 32);
    LAS bf16* stg_e = stg + r32e;
    const bf16* gp = GATED ? P.G + orow0 * P.ldg : nullptr;
#pragma unroll
    for (int r = 0; r < 16; ++r) { const int orow = crow(r, hie); const float rl = __builtin_amdgcn_rcpf(li_l[orow]);
#pragma unroll
        for (int d0 = 0; d0 < NCB; ++d0) { float v = o[d0][r] * rl;
            if constexpr (GATED) { const float gte = bf2f(gp[(unsigned)(orow * P.ldg + d0 * 32 + r32e)]); v *= silu(gte); }
            stg_e[orow * DV + d0 * 32] = (bf16)f2bf(v); } }
    asm volatile("s_waitcnt lgkmcnt(0)" ::: "memory");
    constexpr int CPR = DV / 8, RPI = 64 / CPR;
    bf16* op = P.O + orow0 * P.ldo;
#pragma unroll
    for (int i = 0; i < 32 / RPI; ++i) { const int row = i * RPI + lane_e / CPR, ch = lane_e % CPR;
        const v4u v = *(const LAS v4u*)(stg + row * DV + ch * 8); *(GAS v4u*)(op + (unsigned)(row * P.ldo + ch * 8)) = v; }
    __syncthreads();
#undef SLOAD
#undef SWRITE
#undef SWAIT
#undef RESC
#undef NEGM
#undef MASKT
}
#undef SBAR
}

__device__ __forceinline__ void mla_prep_rows(Frame& F) {
    const int gw = F.vcu * NWAVES + F.wave, NGW = F.G * NWAVES, lane = F.lane;
    const bf16* P = (const bf16*)(F.ws + WS_B);
    bf16* cqn = (bf16*)(F.ws + WS_MASK); bf16* ckvn = (bf16*)(F.ws + WS_MASK + 8 * MiB); bf16* krope = (bf16*)(F.ws + WS_KROPE);
    const float* cosD = (const float*)(F.ws + WS_ROPE) + (size_t)M * 64; const float* sinD = cosD + (size_t)M * 16;
    for (int t = gw; t < M; t += NGW) {
        const bf16* pr = P + (size_t)t * N1;
        { const u32x2 w = *(const GAS u32x2*)(pr + C1_DCQ + 4 * lane); const float a = bflo(w.x), b = bfhi(w.x), c = bflo(w.y), d = bfhi(w.y);
          const float r = 1.0f / sqrtf(wave_sum(a * a + b * b + c * c + d * d) * (1.f / 256.f) + NORM_EPS);
          const f32x4 g = *(const GAS f32x4*)(F.q_norm + 4 * lane);
          *(GAS u32x2*)(cqn + (size_t)t * 256 + 4 * lane) = (u32x2){pk2(a * r * g.x, b * r * g.y), pk2(c * r * g.z, d * r * g.w)}; }
        { const unsigned w = *(const GAS unsigned*)(pr + C1_DCKV + 2 * lane); const float a = bflo(w), b = bfhi(w);
          const float r = 1.0f / sqrtf(wave_sum(a * a + b * b) * (1.f / 128.f) + NORM_EPS);
          *(GAS unsigned*)(ckvn + (size_t)t * 128 + 2 * lane) = pk2(a * r * F.kv_norm[2 * lane], b * r * F.kv_norm[2 * lane + 1]); }
        if (lane < 16) { const float x1 = bf2f(pr[C1_DKR + lane]), x2 = bf2f(pr[C1_DKR + 16 + lane]); const float c = cosD[(size_t)t * 16 + lane], s = sinD[(size_t)t * 16 + lane];
          krope[(size_t)t * 32 + lane] = (bf16)f2bf(x1 * c - x2 * s); krope[(size_t)t * 32 + 16 + lane] = (bf16)f2bf(x1 * s + x2 * c); }
    }
}
__device__ __forceinline__ void diff_finalize_rows(Frame& F) {
    const int gw = F.vcu * NWAVES + F.wave, NGW = F.G * NWAVES, lane = F.lane;
    const bf16* P = (const bf16*)(F.ws + WS_B); const bf16* oC = (const bf16*)(F.ws + WS_MASK); bf16* MIX = (bf16*)(F.ws + WS_A);
    const float lam_init = 0.8f - 0.6f * 0.74081822068171786607f;
    const float d1 = wave_sum(F.diff_lambda[lane] * F.diff_lambda[64 + lane]), d2 = wave_sum(F.diff_lambda[128 + lane] * F.diff_lambda[192 + lane]);
    const float lam = __expf(d1) - __expf(d2) + lam_init;
    const int h = lane >> 4, e0 = (lane & 15) * 8;
    float sub[8];
#pragma unroll
    for (int j = 0; j < 8; ++j) sub[j] = F.diff_subln[e0 + j] * (1.0f - lam_init);
    for (int t = gw; t < M; t += NGW) {
        const v4u a = *(const GAS v4u*)(oC + (size_t)t * 1024 + h * 128 + e0), b = *(const GAS v4u*)(oC + (size_t)t * 1024 + (4 + h) * 128 + e0);
        const v4u gv = *(const GAS v4u*)(P + (size_t)t * N1 + C1_CG + h * 128 + e0);
        const unsigned aw[4] = {a.x, a.y, a.z, a.w}, bw[4] = {b.x, b.y, b.z, b.w}, gw4[4] = {gv.x, gv.y, gv.z, gv.w};
        float d[8]; float s = 0.f;
#pragma unroll
        for (int j = 0; j < 8; ++j) { const float x = (j & 1) ? bfhi(aw[j >> 1]) : bflo(aw[j >> 1]), y = (j & 1) ? bfhi(bw[j >> 1]) : bflo(bw[j >> 1]); d[j] = x - lam * y; s += d[j] * d[j]; }
        s += __shfl_xor(s, 1); s += __shfl_xor(s, 2); s += __shfl_xor(s, 4); s += __shfl_xor(s, 8);
        const float r = 1.0f / sqrtf(s * (1.f / 128.f) + NORM_EPS);
        float o[8];
#pragma unroll
        for (int j = 0; j < 8; ++j) { const float g = (j & 1) ? bfhi(gw4[j >> 1]) : bflo(gw4[j >> 1]); o[j] = d[j] * r * sub[j] * silu(g); }
        *(GAS v4u*)(MIX + (size_t)t * DM + h * 128 + e0) = (v4u){pk2(o[0], o[1]), pk2(o[2], o[3]), pk2(o[4], o[5]), pk2(o[6], o[7])};
    }
}

constexpr int N_PHASES = 14;
struct Args { const void* in[14]; float* out; unsigned char* ws; int ph_lo, ph_hi; };
__global__ void __launch_bounds__(NWAVES * 64, 2) fwd_kernel(Args args) {
    extern __shared__ __attribute__((aligned(16))) unsigned char lds[];
    Frame F;
    F.lds = (LAS unsigned char*)lds;
    F.MISC = (volatile LAS unsigned*)(F.lds + MISC_OFF);
    F.tid = threadIdx.x; F.lane = F.tid & 63; F.wave = __builtin_amdgcn_readfirstlane(F.tid >> 6);
    F.G = gridDim.x; { const int bx = blockIdx.x; F.vcu = (F.G % 8 == 0) ? (bx % 8) * (F.G / 8) + bx / 8 : bx; }
    F.ws = args.ws; F.ctl = (gu32*)(args.ws + WS_CTL);
    F.x = (const float*)args.in[0]; F.pos = (const int*)args.in[1]; F.pre_norm = (const float*)args.in[2]; F.post_norm = (const float*)args.in[3];
    F.w_in_even = (const float*)args.in[4]; F.w_out_even = (const float*)args.in[5]; F.w_in_odd = (const float*)args.in[6]; F.diff_lambda = (const float*)args.in[7];
    F.diff_subln = (const float*)args.in[8]; F.q_norm = (const float*)args.in[9]; F.kv_norm = (const float*)args.in[10]; F.w_uq = (const float*)args.in[11];
    F.w_ukv = (const float*)args.in[12]; F.w_out_odd = (const float*)args.in[13]; F.out = args.out;
    for (int u = F.tid; u < (LDS_BYTES - LDSCTL_OFF) / 4; u += NWAVES * 64) ((LAS unsigned*)(F.lds + LDSCTL_OFF))[u] = 0u;
    __syncthreads();
    XcdBarrier bar; bar.bar = (unsigned*)(F.ctl + CW_BAR); bar.x = 0; bar.st = nullptr;
    if (MK_N_LAUNCHES == 1) bar = xcd_barrier_post((unsigned*)(F.ctl + CW_BAR), F.MISC + 8);
    const int lo = args.ph_lo, hi = args.ph_hi;
#ifdef ONLY_PHASE
#define IN(k) ((k) == ONLY_PHASE && lo <= (k) && (k) < hi)
#else
#define IN(k) (lo <= (k) && (k) < hi)
#endif
#ifndef PROBE_DUP
#define PROBE_DUP 0
#endif
#define REP(k)
#define SEAM(k) do { if (MK_N_LAUNCHES == 1 && IN(k) && IN((k) + 1)) xcd_barrier(bar); } while (0)
    bf16* const HA = (bf16*)(F.ws + WS_A);
    bf16* const PB = (bf16*)(F.ws + WS_B);
    float* const MB = (float*)(F.ws + WS_B);
    LAS char* const alds = (LAS char*)(F.lds + RING_OFF);

    if (IN(0)) { p0_prologue(F); }
    SEAM(0);
#if MK_STAGE == 1
    if (IN(1)) { const int gt = F.vcu * (NWAVES * 64) + F.tid, NGT = F.G * NWAVES * 64; for (size_t e = gt; e < (size_t)M * DM / 4; e += NGT) ((f32x4*)F.out)[e] = ((const f32x4*)F.x)[e]; }
#else
    if (IN(1)) REP(1) { __syncthreads(); pg8::Gemm g{HA, (const bf16*)(F.ws + WS_W0T), M, N0, DM}; pg8::StaticOrder S; S.init(M, N0, F.G, (int)blockIdx.x);
        pg8::EpiBf16<0> E{PB, N0, nullptr, 512, 512, 0.125f * 1.4426950408889634f};
        pg8::gemm_phase<pg8::EpiBf16<0>, pg8::StaticOrder, true, true>(F.lds + RING_OFF, g, S, E); }
    SEAM(1);
    if (IN(2)) REP(2) { __syncthreads();
        for (int it = F.vcu; it < 512; it += F.G) ret_u_item(F, it);
        for (int c = F.vcu; c < 256; c += F.G) { const int b = c >> 7, gi = c & 127;
#pragma unroll 1
            for (int k = 0; k < 2; ++k) idx_item(F, b, k ? gi : 255 - gi); }
    }
    SEAM(2);
    if (IN(3)) { ret_scan(F); }
    SEAM(3);
    if (IN(4)) REP(4) { __syncthreads();
#if defined(DBG_NO_A) || defined(DBG_NO_RET)
        { const int gt = F.vcu * (NWAVES * 64) + F.tid, NGT = F.G * NWAVES * 64;
          for (size_t e = gt; e < (size_t)M * 64; e += NGT) { const size_t row = e >> 6, c8 = (e & 63) * 8;
#ifdef DBG_NO_A
              *(v4u*)(HA + row * DM + c8) = (v4u){0u, 0u, 0u, 0u};
#endif
#ifdef DBG_NO_RET
              *(v4u*)(HA + row * DM + 512 + c8) = (v4u){0u, 0u, 0u, 0u};
#endif
          } }
#endif
#ifndef DBG_NO_A
        for (int pu = F.vcu; pu < 256; pu += F.G) {
            const int bh = pu >> 4, s = pu & 15, b = bh >> 3, h = bh & 7;
            att::AttnP A;
            const bf16* Pb = PB + (size_t)b * T * N0;
            A.Q = Pb + C0_AQ + h * 64; A.K = Pb + C0_AK + h * 64; A.K2 = nullptr; A.V = Pb + C0_AV + h * 64; A.G = Pb + C0_AG + h * 64;
            A.O = HA + (size_t)b * T * DM + h * 64; A.mask = (const unsigned*)(F.ws + WS_MASK) + (size_t)b * T * 256; A.cs = nullptr; A.sn = nullptr;
            A.ldq = N0; A.ldk = N0; A.ldk2 = 0; A.ldv = N0; A.ldo = DM; A.ldg = N0; A.C = 0.125f * 1.4426950408889634f;
#pragma unroll 1
            for (int k = 0; k < 2; ++k) att::attn_unit<64, 64, true, true, false>(A, k ? s : 31 - s, alds, F.tid);
        }
#endif
#ifndef DBG_NO_RET
        for (int it = F.vcu; it < 512; it += F.G) ret_out_item(F, it);
#endif
    }
    SEAM(4);
    if (IN(5)) REP(5) { __syncthreads(); pg8::Gemm g{HA, (const bf16*)(F.ws + WS_WO0T), M, DM, DM}; pg8::StaticOrder S; S.init(M, DM, F.G, (int)blockIdx.x);
        EpiF32 E{MB, DM};
        pg8::gemm_phase<EpiF32, pg8::StaticOrder, false, true>(F.lds + RING_OFF, g, S, E); }
    SEAM(5);
    if (IN(6)) REP(6) { __syncthreads(); post_norm_rows<true>(F, F.x, MB, F.post_norm, F.pre_norm + DM, F.out, HA); }
    SEAM(6);
#if MK_STAGE >= 3
    if (IN(7)) REP(7) { __syncthreads(); pg8::Gemm g{HA, (const bf16*)(F.ws + WS_W1T), M, N1, DM}; pg8::StaticOrder S; S.init(M, N1, F.G, (int)blockIdx.x);
        pg8::EpiBf16<0> E{PB, N1, nullptr, 512, 512, 0.125f * 1.4426950408889634f};
        pg8::gemm_phase<pg8::EpiBf16<0>, pg8::StaticOrder, true, true>(F.lds + RING_OFF, g, S, E); }
    SEAM(7);
    if (IN(8)) REP(8) { __syncthreads(); mla_prep_rows(F); }
    SEAM(8);
    if (IN(9)) REP(9) { __syncthreads();
        { pg8::Gemm g{(const bf16*)(F.ws + WS_MASK), (const bf16*)(F.ws + WS_WUQT), M, 768, 256}; pg8::StaticOrder S; S.init(M, 768, F.G, (int)blockIdx.x);
          pg8::EpiBf16<0> E{(bf16*)(F.ws + WS_QD), 768, nullptr, 768, 768, 0.10206207261596575f * 1.4426950408889634f};
          pg8::gemm_phase<pg8::EpiBf16<0>, pg8::StaticOrder, true, true>(F.lds + RING_OFF, g, S, E); }
        __syncthreads();
        { pg8::Gemm g{(const bf16*)(F.ws + WS_MASK + 8 * MiB), (const bf16*)(F.ws + WS_WUKVT), M, 1024, 128}; pg8::StaticOrder S; S.init(M, 1024, F.G, (int)blockIdx.x);
          pg8::EpiBf16<0> E{(bf16*)(F.ws + WS_KVX), 1024, nullptr, 0, 0, 1.f};
          pg8::gemm_phase<pg8::EpiBf16<0>, pg8::StaticOrder, true, true>(F.lds + RING_OFF, g, S, E); }
    }
    SEAM(9);
    if (IN(10)) REP(10) { __syncthreads();
        for (int pu = F.vcu; pu < 256; pu += F.G) {
            const int bh = pu >> 4, s = pu & 15, b = bh >> 3, hs = bh & 7;
#ifndef PH10_NO_C
            {   att::AttnP A; const bf16* Pb = PB + (size_t)b * T * N1; const int h = hs & 3, mp = hs >> 2;
                A.Q = Pb + C1_CQ + h * 128 + 64 * mp; A.K = Pb + C1_CK + h * 128 + 64 * mp; A.K2 = nullptr; A.V = Pb + C1_CV + h * 128; A.G = nullptr;
                A.O = (bf16*)(F.ws + WS_MASK) + (size_t)b * T * 1024 + hs * 128; A.mask = nullptr; A.cs = nullptr; A.sn = nullptr;
                A.ldq = N1; A.ldk = N1; A.ldk2 = 0; A.ldv = N1; A.ldo = 1024; A.ldg = 0; A.C = 0.125f * 1.4426950408889634f;
#pragma unroll 1
                for (int k = 0; k < 2; ++k) att::attn_unit<64, 128, false, false, false>(A, k ? s : 31 - s, alds, F.tid); }
#endif
#ifndef PH10_NO_D
            {   att::AttnP A; const int h = hs;
                A.Q = (const bf16*)(F.ws + WS_QD) + (size_t)b * T * 768 + h * 96; A.K = (const bf16*)(F.ws + WS_KVX) + (size_t)b * T * 1024 + h * 128;
                A.K2 = (const bf16*)(F.ws + WS_KROPE) + (size_t)b * T * 32; A.V = (const bf16*)(F.ws + WS_KVX) + (size_t)b * T * 1024 + h * 128 + 64;
                A.G = PB + (size_t)b * T * N1 + C1_DG + h * 64; A.O = HA + (size_t)b * T * DM + 512 + h * 64; A.mask = nullptr;
                A.cs = (const float*)(F.ws + WS_ROPE) + (size_t)M * 64 + (size_t)b * T * 16; A.sn = A.cs + (size_t)M * 16;
                A.ldq = 768; A.ldk = 1024; A.ldk2 = 32; A.ldv = 1024; A.ldo = DM; A.ldg = N1; A.C = 0.10206207261596575f * 1.4426950408889634f;
#pragma unroll 1
                for (int k = 0; k < 2; ++k) att::attn_unit<96, 64, false, true, true>(A, k ? s : 31 - s, alds, F.tid); }
#endif
        }
    }
    SEAM(10);
    if (IN(11)) REP(11) { __syncthreads(); diff_finalize_rows(F); }
    SEAM(11);
    if (IN(12)) REP(12) { __syncthreads(); pg8::Gemm g{HA, (const bf16*)(F.ws + WS_WO1T), M, DM, DM}; pg8::StaticOrder S; S.init(M, DM, F.G, (int)blockIdx.x);
        EpiF32 E{MB, DM};
        pg8::gemm_phase<EpiF32, pg8::StaticOrder, false, true>(F.lds + RING_OFF, g, S, E); }
    SEAM(12);
    if (IN(13)) { post_norm_rows<false>(F, F.out, MB, F.post_norm + DM, nullptr, F.out, nullptr); }
#endif
#endif
#undef IN
#undef SEAM
}

extern "C" void kernel_launch(void* const* d_in, const int* in_sizes, int n_in, void* d_out, int out_size, void* d_ws, size_t ws_size, hipStream_t stream) {
    static int grid = 0;
    if (grid == 0) {
        if (n_in != 14 || in_sizes[0] != M * DM || out_size != M * DM || ws_size < WS_END) { fprintf(stderr, "kernel_launch: unexpected shapes (n_in %d, in0 %d, out %d, ws %zu); nothing launched\n", n_in, n_in > 0 ? in_sizes[0] : -1, out_size, ws_size); grid = -1; return; }
        int dev = 0, cus = 0, per_cu = 0;
        if (hipGetDevice(&dev) != hipSuccess || hipDeviceGetAttribute(&cus, hipDeviceAttributeMultiprocessorCount, dev) != hipSuccess) { grid = -1; return; }
        if (hipFuncSetAttribute((const void*)fwd_kernel, hipFuncAttributeMaxDynamicSharedMemorySize, LDS_BYTES) != hipSuccess) { fprintf(stderr, "kernel_launch: hipFuncSetAttribute failed\n"); grid = -1; return; }
        if (hipOccupancyMaxActiveBlocksPerMultiprocessor(&per_cu, (const void*)fwd_kernel, NWAVES * 64, LDS_BYTES) != hipSuccess || per_cu < 1)
            fprintf(stderr, "kernel_launch: note: occupancy query reports %d workgroups per CU\n", per_cu);
        (void)hipGetLastError();
        grid = cus;
    }
    if (grid < 0) return;
    if (hipMemsetAsync((char*)d_ws + WS_CTL, 0, CTL_ZERO_BYTES, stream) != hipSuccess) { fprintf(stderr, "kernel_launch: hipMemsetAsync failed\n"); return; }
    Args a{};
    for (int i = 0; i < 14; ++i) a.in[i] = d_in[i];
    a.out = (float*)d_out; a.ws = (unsigned char*)d_ws;
#if MK_N_LAUNCHES == 1
    a.ph_lo = 0; a.ph_hi = N_PHASES;
    hipLaunchKernelGGL(fwd_kernel, dim3(grid), dim3(NWAVES * 64), LDS_BYTES, stream, a);
#else
    for (int p = 0; p < N_PHASES; ++p) { a.ph_lo = p; a.ph_hi = p + 1; const int reps = ((PROBE_DUP >> p) & 1) ? 2 : 1;
        for (int r = 0; r < reps; ++r) hipLaunchKernelGGL(fwd_kernel, dim3(grid), dim3(NWAVES * 64), LDS_BYTES, stream, a); }
#endif
    const hipError_t le = hipPeekAtLastError();
    if (le != hipSuccess) fprintf(stderr, "kernel_launch: launch failed: %s\n", hipGetErrorName(le));
}
```
